# Optimizing an MI355X kernel written in HIP

```python
import math
import jax, jax.numpy as jnp
from jax import lax
import numpy as np

D_MODEL = 1024
BATCH = 32
SEQ = 256
DEPTH = 2
DEC_BATCH = 8
DEC_SEQ = 4096
PAST_LEN = 512

GRID_W = 64
F_GROUPS = 4
F_GROUP_DIM = 64
F_WIDTH = F_GROUPS * F_GROUP_DIM
MLA_HEADS = 8
QK_NOPE = 64
QK_ROPE = 32
V_DIM = 64
Q_LORA = 256
KV_LORA = 128
MLA_WIDTH = MLA_HEADS * V_DIM
GLA_HEADS = 4
GLA_DK = 32
GLA_DV = 64
GLA_WIDTH = GLA_HEADS * GLA_DV
GLA_GATE_RANK = 16
GLA_TAU = 16.0
GLA_CHUNK = 64
D_FF = 4 * D_MODEL
N_BRANCH = 3
ROPE_BASE = 10000.0
NORM_EPS = 1e-6
Q_BLOCK = 128
IN_SIZES = (F_WIDTH, Q_LORA, KV_LORA, QK_ROPE, GLA_HEADS * GLA_DK, GLA_HEADS * GLA_DK,
            GLA_WIDTH, GLA_WIDTH, GLA_GATE_RANK, GLA_GATE_RANK, N_BRANCH * D_MODEL)
D_IN = F_WIDTH + Q_LORA + KV_LORA + QK_ROPE + 2 * GLA_HEADS * GLA_DK + 2 * GLA_WIDTH + 2 * GLA_GATE_RANK + N_BRANCH * D_MODEL

kernel_name = 'hybrid_fourier_mla_gla_prefix_dit_step'


def rms_norm(x, g=None):
    xf = x.astype(jnp.float32)
    y = xf * lax.rsqrt(jnp.mean(xf * xf, axis=-1, keepdims=True) + NORM_EPS)
    if g is not None:
        y = y * g.astype(jnp.float32)
    return y.astype(x.dtype)


def split_cols(z, sizes):
    idx = [int(v) for v in np.cumsum(np.array(sizes))[:-1]]
    return jnp.split(z, idx, axis=-1)


def axial_rope(x):
    L = x.shape[1]
    rows = L // GRID_W
    row = jnp.repeat(jnp.arange(rows), GRID_W)
    col = jnp.tile(jnp.arange(GRID_W), rows)
    half = QK_ROPE // 2
    inv = ROPE_BASE ** (-jnp.arange(0, half, 2, dtype=jnp.float32) / half)

    def rot(xh, pos):
        ang = pos.astype(jnp.float32)[:, None] * inv[None, :]
        cos = jnp.cos(ang)[None, :, None, :]
        sin = jnp.sin(ang)[None, :, None, :]
        a, b = jnp.split(xh.astype(jnp.float32), 2, axis=-1)
        return jnp.concatenate([a * cos - b * sin, a * sin + b * cos], axis=-1)

    out = jnp.concatenate([rot(x[..., :half], row), rot(x[..., half:], col)], axis=-1)
    return out.astype(x.dtype)


def attend(q, k, v):
    B, L, H, dq = q.shape
    dv = v.shape[-1]
    blk = math.gcd(L, Q_BLOCK)
    n = L // blk
    qb = q.reshape(B, n, blk, H, dq).transpose(1, 0, 2, 3, 4)
    scale = dq ** -0.5

    def one(qi):
        s = jnp.einsum('bqhd,bkhd->bhqk', qi, k, preferred_element_type=jnp.float32) * scale
        p = jax.nn.softmax(s, axis=-1)
        return jnp.einsum('bhqk,bkhe->bqhe', p.astype(v.dtype), v)

    o = lax.map(one, qb)
    return o.transpose(1, 0, 2, 3, 4).reshape(B, L, H * dv)


def gla_chunked(q, k, v, log_a, s0):
    B, L, H, DK = q.shape
    DV = v.shape[-1]
    C = math.gcd(L, GLA_CHUNK)
    n = L // C

    def to_chunks(t):
        return t.reshape(B, n, C, H, t.shape[-1]).transpose(1, 0, 3, 2, 4)

    causal = jnp.tril(jnp.ones((C, C), dtype=bool))[None, None, :, :, None]

    def step(S, inp):
        qi, ki, vi, gi = inp
        b = jnp.cumsum(gi, axis=2)
        inter = jnp.einsum('bhid,bhde->bhie', qi * jnp.exp(b), S)
        diff = b[:, :, :, None, :] - b[:, :, None, :, :]
        decay = jnp.where(causal, jnp.exp(jnp.minimum(diff, 0.0)), 0.0)
        scores = jnp.einsum('bhid,bhjd,bhijd->bhij', qi, ki, decay)
        intra = jnp.einsum('bhij,bhje->bhie', scores, vi)
        b_last = b[:, :, -1:, :]
        S_new = jnp.exp(b_last[:, :, 0, :])[..., None] * S + jnp.einsum(
            'bhjd,bhje->bhde', ki * jnp.exp(b_last - b), vi)
        return S_new, inter + intra

    S_fin, o = lax.scan(step, s0, (to_chunks(q), to_chunks(k), to_chunks(v), to_chunks(log_a)))
    o = o.transpose(1, 0, 3, 2, 4).reshape(B, L, H, DV)
    return o, S_fin


def mixer(h, p, ctx):
    B, L, _ = h.shape
    z = h @ p['w_in']
    zf, zqd, zkvd, zkr, zgq, zgk, zgv, zgr, zaf, zab, zgate = split_cols(z, IN_SIZES)

    f = zf.reshape(B, L, F_GROUPS, F_GROUP_DIM).astype(jnp.float32)
    f = jnp.real(jnp.fft.fft2(f, axes=(1, 3), norm='ortho')).reshape(B, L, F_WIDTH).astype(h.dtype)
    y_a = f @ p['w_o_fourier']

    cq = rms_norm(zqd, p['mla_q_norm_g'])
    q = (cq @ p['w_q_up']).reshape(B, L, MLA_HEADS, QK_NOPE + QK_ROPE)
    ckv = rms_norm(zkvd, p['mla_kv_norm_g'])
    k_rope = zkr
    if ctx is None:
        q_att = q
        ckv_all, kr_all = ckv, k_rope
    else:
        q_att = jnp.concatenate([q[..., :QK_NOPE], axial_rope(q[..., QK_NOPE:])], axis=-1)
        kr_lat = axial_rope(k_rope[:, :, None, :])[:, :, 0, :]
        ckv_all = jnp.concatenate([ctx[0].astype(ckv.dtype), ckv], axis=1)
        kr_all = jnp.concatenate([ctx[1].astype(kr_lat.dtype), kr_lat], axis=1)
    Lk = ckv_all.shape[1]
    kv = (ckv_all @ p['w_kv_up']).reshape(B, Lk, MLA_HEADS, QK_NOPE + V_DIM)
    k_nope, v = kv[..., :QK_NOPE], kv[..., QK_NOPE:]
    k = jnp.concatenate(
        [k_nope, jnp.broadcast_to(kr_all[:, :, None, :], (B, Lk, MLA_HEADS, QK_ROPE))], axis=-1)
    y_b = attend(q_att, k, v) @ p['w_o_mla']

    f32 = jnp.float32
    gq = zgq.reshape(B, L, GLA_HEADS, GLA_DK).astype(f32) * (GLA_DK ** -0.5)
    gk = zgk.reshape(B, L, GLA_HEADS, GLA_DK).astype(f32)
    gv = zgv.reshape(B, L, GLA_HEADS, GLA_DV).astype(f32)
    la_f = jax.nn.log_sigmoid((zaf @ p['gla_wa2_f'] + p['gla_ba_f']).astype(f32)) / GLA_TAU
    la_b = jax.nn.log_sigmoid((zab @ p['gla_wa2_b'] + p['gla_ba_b']).astype(f32)) / GLA_TAU
    la_f = la_f.reshape(B, L, GLA_HEADS, GLA_DK)
    la_b = la_b.reshape(B, L, GLA_HEADS, GLA_DK)
    if ctx is None:
        s0_f = jnp.zeros((B, GLA_HEADS, GLA_DK, GLA_DV), f32)
        s0_b = jnp.zeros((B, GLA_HEADS, GLA_DK, GLA_DV), f32)
    else:
        s0_f = ctx[2].astype(f32)
        s0_b = ctx[3].astype(f32)
    o_f, s_f = gla_chunked(gq, gk, gv, la_f, s0_f)
    o_b, s_b = gla_chunked(jnp.flip(gq, 1), jnp.flip(gk, 1), jnp.flip(gv, 1), jnp.flip(la_b, 1), s0_b)
    o_g = rms_norm(o_f + jnp.flip(o_b, 1)).reshape(B, L, GLA_WIDTH) * p['gla_norm_g'].astype(f32)
    o_g = (o_g * jax.nn.silu(zgr.astype(f32))).astype(h.dtype)
    y_c = o_g @ p['w_o_gla']

    g = jax.nn.sigmoid(zgate.astype(f32)).astype(h.dtype).reshape(B, L, N_BRANCH, D_MODEL)
    merged = g[:, :, 0] * y_a + g[:, :, 1] * y_b + g[:, :, 2] * y_c
    out = merged @ p['w_out']
    return out, (ckv, k_rope, s_f.astype(h.dtype), s_b.astype(h.dtype))


def layer(x, cond, p, ctx):
    mod = (jax.nn.silu(cond) @ p['w_mod'] + p['b_mod'])[:, None, :]
    shift1, scale1, gate1, shift2, scale2, gate2 = jnp.split(mod, 6, axis=-1)
    h = rms_norm(x, p['norm1_g']) * (1 + scale1) + shift1
    out, ctx_out = mixer(h, p, ctx)
    x = x + gate1 * out
    h2 = rms_norm(x, p['norm2_g']) * (1 + scale2) + shift2
    x = x + gate2 * (jnp.square(jax.nn.relu(h2 @ p['w_ff1'])) @ p['w_ff2'])
    return x, ctx_out


def setup_inputs(seed: int = 0) -> dict:
    key = jax.random.key(seed)
    ks = jax.random.split(key, 32)

    def nrm(k, shape, s):
        return jax.random.normal(k, shape, jnp.float32) * s

    return {
        'x_prompt': nrm(ks[0], (BATCH, SEQ, D_MODEL), 1.0),
        'x_sample': nrm(ks[1], (DEC_BATCH, DEC_SEQ, D_MODEL), 1.0),
        'c': nrm(ks[2], (DEC_BATCH, D_MODEL), 1.0),
        'cache_mla_ckv': nrm(ks[3], (DEC_BATCH, DEPTH, PAST_LEN, KV_LORA), 1.0),
        'cache_mla_krope': nrm(ks[4], (DEC_BATCH, DEPTH, PAST_LEN, QK_ROPE), 1.0),
        'state_gla': nrm(ks[5], (DEC_BATCH, DEPTH, 2, GLA_HEADS, GLA_DK, GLA_DV), 0.3),
        'c_ctx': nrm(ks[6], (D_MODEL,), 1.0),
        'w_mod': nrm(ks[7], (DEPTH, D_MODEL, 6 * D_MODEL), D_MODEL ** -0.5),
        'b_mod': nrm(ks[8], (DEPTH, 6 * D_MODEL), 0.02),
        'norm1_g': 1.0 + nrm(ks[9], (DEPTH, D_MODEL), 0.05),
        'w_in': nrm(ks[10], (DEPTH, D_MODEL, D_IN), D_MODEL ** -0.5),
        'mla_q_norm_g': 1.0 + nrm(ks[11], (DEPTH, Q_LORA), 0.05),
        'mla_kv_norm_g': 1.0 + nrm(ks[12], (DEPTH, KV_LORA), 0.05),
        'w_q_up': nrm(ks[13], (DEPTH, Q_LORA, MLA_HEADS * (QK_NOPE + QK_ROPE)), Q_LORA ** -0.5),
        'w_kv_up': nrm(ks[14], (DEPTH, KV_LORA, MLA_HEADS * (QK_NOPE + V_DIM)), KV_LORA ** -0.5),
        'gla_wa2_f': nrm(ks[15], (DEPTH, GLA_GATE_RANK, GLA_HEADS * GLA_DK), GLA_GATE_RANK ** -0.5),
        'gla_ba_f': nrm(ks[16], (DEPTH, GLA_HEADS * GLA_DK), 0.5),
        'gla_wa2_b': nrm(ks[17], (DEPTH, GLA_GATE_RANK, GLA_HEADS * GLA_DK), GLA_GATE_RANK ** -0.5),
        'gla_ba_b': nrm(ks[18], (DEPTH, GLA_HEADS * GLA_DK), 0.5),
        'gla_norm_g': 1.0 + nrm(ks[19], (DEPTH, GLA_WIDTH), 0.05),
        'w_o_fourier': nrm(ks[20], (DEPTH, F_WIDTH, D_MODEL), F_WIDTH ** -0.5),
        'w_o_mla': nrm(ks[21], (DEPTH, MLA_WIDTH, D_MODEL), MLA_WIDTH ** -0.5),
        'w_o_gla': nrm(ks[22], (DEPTH, GLA_WIDTH, D_MODEL), GLA_WIDTH ** -0.5),
        'w_out': nrm(ks[23], (DEPTH, D_MODEL, D_MODEL), D_MODEL ** -0.5),
        'norm2_g': 1.0 + nrm(ks[24], (DEPTH, D_MODEL), 0.05),
        'w_ff1': nrm(ks[25], (DEPTH, D_MODEL, D_FF), D_MODEL ** -0.5),
        'w_ff2': nrm(ks[26], (DEPTH, D_FF, D_MODEL), D_FF ** -0.5),
        'final_norm_g': 1.0 + nrm(ks[27], (D_MODEL,), 0.05),
    }


def reference(x_prompt, x_sample, c, cache_mla_ckv, cache_mla_krope, state_gla, c_ctx,
              w_mod, b_mod, norm1_g, w_in, mla_q_norm_g, mla_kv_norm_g, w_q_up, w_kv_up,
              gla_wa2_f, gla_ba_f, gla_wa2_b, gla_ba_b, gla_norm_g, w_o_fourier, w_o_mla,
              w_o_gla, w_out, norm2_g, w_ff1, w_ff2, final_norm_g):
    xp = x_prompt
    xs = x_sample
    cond_ctx = c_ctx[None, :]
    ckv_list, kr_list, gla_list = [], [], []
    for l in range(DEPTH):
        p = dict(w_mod=w_mod[l], b_mod=b_mod[l], norm1_g=norm1_g[l], w_in=w_in[l],
                 mla_q_norm_g=mla_q_norm_g[l], mla_kv_norm_g=mla_kv_norm_g[l],
                 w_q_up=w_q_up[l], w_kv_up=w_kv_up[l], gla_wa2_f=gla_wa2_f[l],
                 gla_ba_f=gla_ba_f[l], gla_wa2_b=gla_wa2_b[l], gla_ba_b=gla_ba_b[l],
                 gla_norm_g=gla_norm_g[l], w_o_fourier=w_o_fourier[l], w_o_mla=w_o_mla[l],
                 w_o_gla=w_o_gla[l], w_out=w_out[l], norm2_g=norm2_g[l], w_ff1=w_ff1[l],
                 w_ff2=w_ff2[l])
        xp, (ckv_c, kr_c, sf_c, sb_c) = layer(xp, cond_ctx, p, None)
        ckv_list.append(ckv_c)
        kr_list.append(kr_c)
        gla_list.append(jnp.stack([sf_c, sb_c], axis=1))
        ctx = (cache_mla_ckv[:, l], cache_mla_krope[:, l], state_gla[:, l, 0], state_gla[:, l, 1])
        xs, _ = layer(xs, c, p, ctx)
    y_prompt = rms_norm(xp, final_norm_g)
    y_sample = rms_norm(xs, final_norm_g)
    new_mla_ckv = jnp.stack(ckv_list, axis=1)
    new_mla_krope = jnp.stack(kr_list, axis=1)
    new_state_gla = jnp.stack(gla_list, axis=1)
    return (y_prompt, y_sample, new_mla_ckv, new_mla_krope, new_state_gla)
```

```cpp
#include <hip/hip_runtime.h>
#include <hip/hip_cooperative_groups.h>
#include <stdint.h>
#include <stdio.h>
namespace cg = cooperative_groups;

typedef unsigned short u16;
typedef __attribute__((ext_vector_type(8))) short bf16x8;
typedef __attribute__((ext_vector_type(4))) float f32x4;
typedef __attribute__((ext_vector_type(16))) float f32x16;
typedef __attribute__((ext_vector_type(4))) unsigned u32x4;

#ifndef MULTI_LAUNCH
#define MULTI_LAUNCH 0
#endif

constexpr int T_ALL = 40960, T_P = 8192;
constexpr int KT_ALL = 45056;
constexpr int Z1 = 1536;
constexpr int NPH_LAYER = 12;
constexpr int NPHASES = 2 * NPH_LAYER + 1;

constexpr long OUT_CKV = 41943040L, OUT_KR = 44040192L, OUT_ST = 44564480L;

constexpr size_t WT_IN1 = 0;
constexpr size_t WT_GATE = WT_IN1 + 1536ul * 1024 * 2;
constexpr size_t WT_QUP = WT_GATE + 3072ul * 1024 * 2;
constexpr size_t WT_KVUP = WT_QUP + 768ul * 256 * 2;
constexpr size_t WT_OF = WT_KVUP + 1024ul * 128 * 2;
constexpr size_t WT_OMLA = WT_OF + 1024ul * 512 * 2;
constexpr size_t WT_OGLA = WT_OMLA + 1024ul * 512 * 2;
constexpr size_t WT_OUT = WT_OGLA + 1024ul * 256 * 2;
constexpr size_t WT_FF1 = WT_OUT + 1024ul * 1024 * 2;
constexpr size_t WT_FF2 = WT_FF1 + 4096ul * 1024 * 2;
constexpr size_t WT_TOTAL = WT_FF2 + 1024ul * 4096 * 2;
constexpr size_t WS_MOD = 2 * WT_TOTAL;
constexpr size_t WS_D1 = WS_MOD + 2ul * 9 * 6144 * 4;
constexpr size_t WS_D2 = WS_D1 + 128ul * 64 * 2;
constexpr size_t WS_H = WS_D2 + 128ul * 128 * 2;
constexpr size_t WS_RA = WS_H + 40960ul * 1024 * 2;
constexpr size_t WS_Z1 = WS_RA;
constexpr size_t WS_KNOPE = WS_Z1 + 40960ul * 1536 * 2;
constexpr size_t WS_VT = WS_KNOPE + 45056ul * 512 * 2;
constexpr size_t WS_GDS = WS_VT + 45056ul * 512 * 2;
constexpr size_t WS_GSS = WS_GDS + 2560ul * 2 * 2048 * 2;
constexpr size_t WS_GDEC = WS_GSS + 2560ul * 2 * 2048 * 2;
constexpr size_t WS_RC = WS_GDEC + 2560ul * 2 * 32 * 4;
constexpr size_t WS_F = WS_RC;
constexpr size_t WS_ATT = WS_F + 40960ul * 512 * 2;
constexpr size_t WS_OG = WS_ATT + 40960ul * 512 * 2;
constexpr size_t WS_CKV = WS_OG + 40960ul * 256 * 2;
constexpr size_t WS_KR = WS_CKV + 45056ul * 128 * 2;
constexpr size_t WS_BAR = WS_KR + 45056ul * 32 * 2;
constexpr size_t WS_END = WS_BAR + 16384;
static_assert(40960ul * 4096 * 2 <= (WS_BAR - WS_RA), "u fits");
constexpr size_t WS_U = WS_RA;
constexpr size_t WS_MERGED = WS_Z1;
constexpr long Q_OFS = 40960L * 1024;
constexpr size_t WS_VP = WS_ATT;

struct Params {
  const float* in[28];
  float* out;
  unsigned char* ws;
  int ph_lo, ph_hi;
};

#ifndef LAUNDER
#define LAUNDER 1
#endif
#define UNROLL_PH 1
#if LAUNDER
__device__ __forceinline__ int opq_s() { int z; asm volatile("s_mov_b32 %0, 0" : "=s"(z)); return z; }
__device__ __forceinline__ int opq_v() { int z; asm volatile("v_mov_b32 %0, 0" : "=v"(z)); return z; }
#else
__device__ __forceinline__ int opq_s() { return 0; }
__device__ __forceinline__ int opq_v() { return 0; }
#endif
__device__ __forceinline__ int ltid() { return (int)threadIdx.x + opq_v(); }
__device__ __forceinline__ int lbid() { return (int)blockIdx.x + opq_s(); }
__device__ __forceinline__ unsigned char* lws(const Params& p) { return p.ws + opq_s(); }
__device__ __forceinline__ float* lout(const Params& p) { return p.out + opq_s(); }
__device__ __forceinline__ unsigned char* lwt(const Params& p, int layer) { return p.ws + opq_s() + (size_t)layer * WT_TOTAL; }
__device__ __forceinline__ const float* pin(const Params& p, int i) { return p.in[i + opq_s()]; }
__device__ __forceinline__ u16 f2bf(float f) { return __builtin_bit_cast(u16, (__bf16)f); }
__device__ __forceinline__ float bf2f(u16 h) { return __uint_as_float(((unsigned)h) << 16); }
typedef __bf16 bf16x2_t __attribute__((ext_vector_type(2)));
typedef float f32x2_t __attribute__((ext_vector_type(2)));
__device__ __forceinline__ unsigned pk2(float a, float b) { f32x2_t v = {a, b}; bf16x2_t r = __builtin_convertvector(v, bf16x2_t); return __builtin_bit_cast(unsigned, r); }
__device__ __forceinline__ float bflo(unsigned w) { return __uint_as_float(w << 16); }
__device__ __forceinline__ float bfhi(unsigned w) { return __uint_as_float(w & 0xffff0000u); }
__device__ __forceinline__ float4 ld_nt4(const float* p) { f32x4 t = __builtin_nontemporal_load((const f32x4*)p); return float4{t[0], t[1], t[2], t[3]}; }
__device__ __forceinline__ void st_nt4(float* p, float4 v) { __builtin_nontemporal_store(f32x4{v.x, v.y, v.z, v.w}, (f32x4*)p); }
__device__ __forceinline__ float cos_rev(float r) { return __builtin_amdgcn_cosf(r); }
__device__ __forceinline__ float sin_rev(float r) { return __builtin_amdgcn_sinf(r); }
__device__ __forceinline__ float xhalf_max(float m) {
  auto r = __builtin_amdgcn_permlane32_swap(__float_as_uint(m), __float_as_uint(m), false, false);
  return fmaxf(__uint_as_float(r[0]), __uint_as_float(r[1]));
}
__device__ __forceinline__ float sigmoidf_(float x) { return __builtin_amdgcn_rcpf(1.f + __builtin_amdgcn_exp2f(-1.4426950408889634f * x)); }
__device__ __forceinline__ float siluf_(float x) { return x * __builtin_amdgcn_rcpf(1.f + __builtin_amdgcn_exp2f(-1.4426950408889634f * x)); }

__device__ __forceinline__ void glds16(const void* g, void* l) {
  __builtin_amdgcn_global_load_lds((const unsigned*)g, (unsigned*)l, 16, 0, 0);
}


#define XB_TMO      128
#define XB_XCNT(j)  (256  + 64 * (j))
#define XB_XSUB(j)  (1280 + 64 * (j))
#define XB_XGEN(j)  (2304 + 64 * (j))
#define XB_TOP      3328
#define XB_TOPGEN   3392
#define XCD_BAR_WORDS 3456
#define XB_SPIN_CAP (1u << 22)
__device__ __forceinline__ unsigned xb_ld(unsigned* p) { return __hip_atomic_load(p, __ATOMIC_RELAXED, __HIP_MEMORY_SCOPE_AGENT); }
__device__ __forceinline__ unsigned xb_add(unsigned* p, unsigned v) { return __hip_atomic_fetch_add(p, v, __ATOMIC_RELAXED, __HIP_MEMORY_SCOPE_AGENT); }
__device__ __forceinline__ unsigned xb_xcc_id() { return (unsigned)__builtin_amdgcn_s_getreg((3 << 11) | 20) & 0xFu; }
#define XB_SPIN(cond, bar) do { unsigned _sp = 0; while (cond) { __builtin_amdgcn_s_sleep(1); \
    if ((++_sp & 255u) == 0u) { if (xb_ld(&(bar)[XB_TMO])) break; if (_sp > XB_SPIN_CAP) { atomicAdd(&(bar)[XB_TMO], 1u); break; } } } } while (0)
struct XcdBarrier { unsigned* bar; unsigned x, nloc, nx; };
__device__ __forceinline__ XcdBarrier xcd_barrier_post(unsigned* bar) {
  XcdBarrier b; b.bar = bar; b.x = xb_xcc_id(); b.nloc = 0u; b.nx = 0u;
  if (threadIdx.x == 0) (void)xb_add(&bar[XB_XCNT(b.x)], 1u);
  return b;
}
__device__ __forceinline__ void xcd_barrier_complete(unsigned* bar, unsigned x, unsigned& nloc, unsigned& nx) {
  const unsigned G = gridDim.x;
  unsigned sum, cnt, mine, sp = 0u;
  for (;;) {
    sum = 0u; cnt = 0u; mine = 0u;
#pragma unroll
    for (unsigned j = 0; j < 16; ++j) { const unsigned c = xb_ld(&bar[XB_XCNT(j)]); sum += c; cnt += (c > 0u) ? 1u : 0u; mine = (j == x) ? c : mine; }
    if (sum == G) break;
    __builtin_amdgcn_s_sleep(1);
    if ((++sp & 255u) == 0u) { if (xb_ld(&bar[XB_TMO])) break; if (sp > XB_SPIN_CAP) { atomicAdd(&bar[XB_TMO], 1u); break; } }
  }
  nloc = mine > 0u ? mine : 1u; nx = cnt > 0u ? cnt : 1u;
}
__device__ __forceinline__ void xcd_barrier(XcdBarrier& b) {
  asm volatile("s_waitcnt vmcnt(0)" ::: "memory");
  __syncthreads();
  if (threadIdx.x == 0) {
    unsigned* bar = b.bar;
    __builtin_amdgcn_s_waitcnt(0);
    if (b.nloc == 0u) xcd_barrier_complete(bar, b.x, b.nloc, b.nx);
    const unsigned nloc = b.nloc, nx = b.nx;
    const unsigned old = xb_add(&bar[XB_XSUB(b.x)], 1u);
    const unsigned gen = old / nloc;
    if (old + 1u == (gen + 1u) * nloc) {
      __builtin_amdgcn_fence(__ATOMIC_RELEASE, "agent");
      asm volatile("s_waitcnt vmcnt(0)" ::: "memory");
      const unsigned og = xb_add(&bar[XB_TOP], 1u);
      const unsigned tg = og / nx;
      if (og + 1u == (tg + 1u) * nx) xb_add(&bar[XB_TOPGEN], 1u);
      else XB_SPIN(xb_ld(&bar[XB_TOPGEN]) == tg, bar);
      __builtin_amdgcn_fence(__ATOMIC_ACQUIRE, "agent");
      xb_add(&bar[XB_XGEN(b.x)], 1u);
      asm volatile("s_waitcnt vmcnt(0)" ::: "memory");
    } else {
      XB_SPIN(xb_ld(&bar[XB_XGEN(b.x)]) == gen, bar);
      __builtin_amdgcn_fence(__ATOMIC_ACQUIRE, "agent");
      asm volatile("s_waitcnt vmcnt(0)" ::: "memory");
    }
  }
  __syncthreads();
}

#define LDSP(p) ((__attribute__((address_space(3))) void*)(p))
struct GemmSrc {
  __amdgpu_buffer_rsrc_t ra, rb;
  int va[4], vb[4];
};
__device__ __forceinline__ GemmSrc gemm_src(const u16* A, long lda, const u16* B, long ldb, int tid) {
  GemmSrc g;
  g.ra = __builtin_amdgcn_make_buffer_rsrc((void*)A, 0, 0x7fffffff, 0x00020000);
  g.rb = __builtin_amdgcn_make_buffer_rsrc((void*)B, 0, 0x7fffffff, 0x00020000);
#pragma unroll
  for (int i = 0; i < 4; ++i) {
    int s = i * 256 + tid;
    int row = s >> 3, cs = s & 7;
    int c = cs ^ ((row >> 1) & 7);
    g.va[i] = (int)((row * lda + c * 8) * 2);
    g.vb[i] = (int)((row * ldb + c * 8) * 2);
  }
  return g;
}
__device__ __forceinline__ void gemm_stage(const GemmSrc& g, int k0, unsigned char* buf, int tid) {
#pragma unroll
  for (int i = 0; i < 4; ++i) {
    __builtin_amdgcn_raw_ptr_buffer_load_lds(g.ra, LDSP(buf + (i * 256 + tid) * 16), 16, g.va[i], k0 * 2, 0, 0);
    __builtin_amdgcn_raw_ptr_buffer_load_lds(g.rb, LDSP(buf + 16384 + (i * 256 + tid) * 16), 16, g.vb[i], k0 * 2, 0, 0);
  }
}

template <int KKU = 2>
__device__ __forceinline__ void gemm_acc(f32x4 (&acc)[4][4], const u16* A, long lda, const u16* B, long ldb, int K, unsigned char* smem, bool swap,
                                         bool prefetched = false, const u16* nA = nullptr, long nlda = 0, const u16* nB = nullptr, long nldb = 0) {
  const int tid = ltid(), wid = __builtin_amdgcn_readfirstlane(tid >> 6), lane = tid & 63, wr = wid >> 1, wc = wid & 1, fr = lane & 15, fq = lane >> 4;
  const int nt = K >> 6;
  const GemmSrc g = gemm_src(A, lda, B, ldb, tid);
  if (!prefetched) gemm_stage(g, 0, smem, tid);
  for (int t = 0; t < nt; ++t) {
    asm volatile("s_waitcnt vmcnt(0)" ::: "memory");
    __syncthreads();
    if (t + 1 < nt) gemm_stage(g, (t + 1) * 64, smem + ((t + 1) & 1) * 32768, tid);
    else if (nA) { const GemmSrc gn = gemm_src(nA, nlda, nB, nldb, tid); gemm_stage(gn, 0, smem, tid); }
    const unsigned char* cb = smem + (t & 1) * 32768;
    if (KKU == 2) {
      bf16x8 a0[4], b0[4], a1[4], b1[4];
#pragma unroll
      for (int m = 0; m < 4; ++m) { int row = wr * 64 + m * 16 + fr; a0[m] = *(const bf16x8*)(cb + row * 128 + ((fq ^ ((row >> 1) & 7)) << 4)); }
#pragma unroll
      for (int n = 0; n < 4; ++n) { int row = wc * 64 + n * 16 + fr; b0[n] = *(const bf16x8*)(cb + 16384 + row * 128 + ((fq ^ ((row >> 1) & 7)) << 4)); }
#pragma unroll
      for (int m = 0; m < 4; ++m) { int row = wr * 64 + m * 16 + fr; a1[m] = *(const bf16x8*)(cb + row * 128 + (((4 + fq) ^ ((row >> 1) & 7)) << 4)); }
#pragma unroll
      for (int n = 0; n < 4; ++n) { int row = wc * 64 + n * 16 + fr; b1[n] = *(const bf16x8*)(cb + 16384 + row * 128 + (((4 + fq) ^ ((row >> 1) & 7)) << 4)); }
      __builtin_amdgcn_sched_barrier(0);
      if (swap) {
#pragma unroll
        for (int m = 0; m < 4; ++m)
#pragma unroll
          for (int n = 0; n < 4; ++n) acc[m][n] = __builtin_amdgcn_mfma_f32_16x16x32_bf16(b0[n], a0[m], acc[m][n], 0, 0, 0);
      } else {
#pragma unroll
        for (int m = 0; m < 4; ++m)
#pragma unroll
          for (int n = 0; n < 4; ++n) acc[m][n] = __builtin_amdgcn_mfma_f32_16x16x32_bf16(a0[m], b0[n], acc[m][n], 0, 0, 0);
      }
      __builtin_amdgcn_sched_barrier(0);
      if (swap) {
#pragma unroll
        for (int m = 0; m < 4; ++m)
#pragma unroll
          for (int n = 0; n < 4; ++n) acc[m][n] = __builtin_amdgcn_mfma_f32_16x16x32_bf16(b1[n], a1[m], acc[m][n], 0, 0, 0);
      } else {
#pragma unroll
        for (int m = 0; m < 4; ++m)
#pragma unroll
          for (int n = 0; n < 4; ++n) acc[m][n] = __builtin_amdgcn_mfma_f32_16x16x32_bf16(a1[m], b1[n], acc[m][n], 0, 0, 0);
      }
    } else {
#pragma unroll 1
      for (int kk = 0; kk < 2; ++kk) {
        bf16x8 af[4], bfr[4];
        const int c = kk * 4 + fq;
#pragma unroll
        for (int m = 0; m < 4; ++m) {
          int row = wr * 64 + m * 16 + fr;
          af[m] = *(const bf16x8*)(cb + row * 128 + ((c ^ ((row >> 1) & 7)) << 4));
        }
#pragma unroll
        for (int n = 0; n < 4; ++n) {
          int row = wc * 64 + n * 16 + fr;
          bfr[n] = *(const bf16x8*)(cb + 16384 + row * 128 + ((c ^ ((row >> 1) & 7)) << 4));
        }
        if (swap) {
#pragma unroll
          for (int m = 0; m < 4; ++m)
#pragma unroll
            for (int n = 0; n < 4; ++n) acc[m][n] = __builtin_amdgcn_mfma_f32_16x16x32_bf16(bfr[n], af[m], acc[m][n], 0, 0, 0);
        } else {
#pragma unroll
          for (int m = 0; m < 4; ++m)
#pragma unroll
            for (int n = 0; n < 4; ++n) acc[m][n] = __builtin_amdgcn_mfma_f32_16x16x32_bf16(af[m], bfr[n], acc[m][n], 0, 0, 0);
        }
      }
    }
  }
  if (!nA) __syncthreads();
}

__device__ __forceinline__ void store_pair16_nt(u16* rowp, uint2 a, uint2 b, int fq) {
  auto r = __builtin_amdgcn_permlane16_swap(a.x, b.x, false, false);
  auto s_ = __builtin_amdgcn_permlane16_swap(a.y, b.y, false, false);
  __builtin_nontemporal_store(u32x4{r[0], s_[0], r[1], s_[1]}, (u32x4*)(rowp + ((fq & 1) << 4) + ((fq >> 1) << 3)));
}
__device__ __forceinline__ void store_pair16(u16* rowp, uint2 a, uint2 b, int fq) {
  auto r = __builtin_amdgcn_permlane16_swap(a.x, b.x, false, false);
  auto s_ = __builtin_amdgcn_permlane16_swap(a.y, b.y, false, false);
  *(u32x4*)(rowp + ((fq & 1) << 4) + ((fq >> 1) << 3)) = u32x4{r[0], s_[0], r[1], s_[1]};
}

__device__ __forceinline__ void zero_acc(f32x4 (&acc)[4][4]) {
#pragma unroll
  for (int m = 0; m < 4; ++m)
#pragma unroll
    for (int n = 0; n < 4; ++n) acc[m][n] = f32x4{0.f, 0.f, 0.f, 0.f};
}


__device__ __forceinline__ void tile_map_n8(int t, int& pm, int& pn) {
  const int x = t & 7, q = t >> 3, j = q & 63, c = x + 8 * (q >> 6);
  pm = c * 8 + (j & 7); pn = j >> 3;
}
__device__ __forceinline__ void tile_map_n32(int t, int& pm, int& pn) {
  const int x = t & 7, q = t >> 3, j = q & 63, c = x + 8 * (q >> 6);
  pm = (c >> 2) * 8 + (j & 7); pn = (c & 3) * 8 + (j >> 3);
}

__device__ __forceinline__ void tile_map_n12(int t, int& pm, int& pn) {
  const int x = t & 7, q = t >> 3;
  int j = q & 63, kk = q >> 6, c;
  if (kk < 7) c = x + 8 * kk;
  else { c = 56 + (x >> 1); j += 32 * (x & 1); }
  const int pr = c / 3, pc = c - pr * 3;
  pm = pr * 16 + (j & 15); pn = pc * 4 + (j >> 4);
}

__device__ __forceinline__ int cond_index(int t) { return t < T_P ? 0 : 1 + ((t - T_P) >> 12); }

__device__ __forceinline__ const float* x_in_row(const Params& p, int layer, int t) {
  if (layer == 0) return t < T_P ? pin(p, 0) + (long)t * 1024 : pin(p, 1) + (long)(t - T_P) * 1024;
  return lout(p) + (long)t * 1024;
}

__device__ const int WD_CNT[9] = {384, 768, 48, 32, 128, 64, 256, 1024, 1024};
__device__ const int WD_TAB[9][5] = {{10, 4544, 0, 1024, 1536}, {10, 4544, 1472, 1024, 3072}, {13, 768, 0, 256, 768}, {14, 1024, 0, 128, 1024},
                                     {21, 1024, 0, 512, 1024},  {22, 1024, 0, 256, 1024},     {23, 1024, 0, 1024, 1024}, {25, 4096, 0, 1024, 4096},
                                     {26, 1024, 0, 4096, 1024}};
__device__ const unsigned long WD_DST[9] = {WT_IN1, WT_GATE, WT_QUP, WT_KVUP, WT_OMLA, WT_OGLA, WT_OUT, WT_FF1, WT_FF2};
__device__ __forceinline__ void transpose_tile(const float* src, int ld, int ncol0, int nvalid, u16* dst, int K, int kt, int nt, unsigned char* smem) {
  float* tile = (float*)smem;
  const int tid = ltid();
  const int k0 = kt * 64, n0 = nt * 64;
#pragma unroll
  for (int i = 0; i < 4; ++i) {
    int k = i * 16 + (tid >> 4), n4 = (tid & 15) * 4;
    int nc = ncol0 + n0 + n4;
    float4 v = (nc < nvalid) ? ld_nt4(src + (long)(k0 + k) * ld + nc) : float4{0.f, 0.f, 0.f, 0.f};
    float* tp = tile + k * 65 + n4;
    tp[0] = v.x; tp[1] = v.y; tp[2] = v.z; tp[3] = v.w;
  }
  __syncthreads();
  {
    int n = tid >> 2, kq = (tid & 3) * 16;
    const float* tp = tile + kq * 65 + n;
    u32x4 w0, w1;
#pragma unroll
    for (int j = 0; j < 4; ++j) {
      w0[j] = pk2(tp[(2 * j) * 65], tp[(2 * j + 1) * 65]);
      w1[j] = pk2(tp[(8 + 2 * j) * 65], tp[(8 + 2 * j + 1) * 65]);
    }
    u16* dp = dst + (long)(n0 + n) * K + k0 + kq;
    *(u32x4*)dp = w0;
    *(u32x4*)(dp + 8) = w1;
  }
  __syncthreads();
}

__device__ __forceinline__ void phase_prep(const Params& p, int layer, unsigned char* smem) {
  const int tid = ltid();
  const int total = 384 + 768 + 48 + 32 + 128 + 64 + 256 + 1024 + 1024;
  const int n_fold = 128;
  const int n_mod = (layer == 0) ? 192 : 0;
  const int n_tab = (layer == 0) ? 96 : 0;
  const int all = total + n_fold + n_mod + n_tab;
  for (int it = lbid(); it < all; it += gridDim.x) {
    if (it < total) {
      int r = it, w = 0;
#pragma unroll 1
      while (r >= WD_CNT[w]) { r -= WD_CNT[w]; ++w; }
      const int in_idx = WD_TAB[w][0], ld = WD_TAB[w][1], ncol0 = WD_TAB[w][2], nvalid = WD_TAB[w][1], K = WD_TAB[w][3], N = WD_TAB[w][4];
      const long lofs = (long)K * ld;
      const size_t dst = WD_DST[w];
      int nN = N / 64;
      transpose_tile(pin(p, in_idx) + (long)layer * lofs, ld, ncol0, nvalid, (u16*)(lwt(p, layer) + dst), K, r / nN, r % nN, smem);
    } else if (it < total + n_fold) {
      int j = it - total;
      int gri = j >> 4, dblk = (j >> 2) & 3, cq = j & 3;
      int g = gri >> 1, ri = gri & 1;
      int d = dblk * 256 + tid;
      float* tab = (float*)smem;
      if (tid < 64) tab[tid] = ri ? sin_rev(tid * (1.f / 64.f)) : cos_rev(tid * (1.f / 64.f));
      __syncthreads();
      const float* W = pin(p, 20) + (long)layer * 256 * 1024 + (long)(g * 64) * 1024 + d;
      float wv[64];
#pragma unroll
      for (int m = 0; m < 64; ++m) wv[m] = W[(long)m * 1024];
      u16* dst = (u16*)(lwt(p, layer) + WT_OF) + (long)d * 512 + g * 128 + ri * 64;
      for (int c = cq * 16; c < cq * 16 + 16; c += 2) {
        float a0 = 0.f, a1 = 0.f;
#pragma unroll
        for (int m = 0; m < 64; ++m) { a0 += wv[m] * tab[(m * c) & 63]; a1 += wv[m] * tab[(m * (c + 1)) & 63]; }
        *(unsigned*)(dst + c) = pk2(a0, a1);
      }
      __syncthreads();
    } else if (it < total + n_fold + n_mod) {
      int j = it - total - n_fold;
      int l = j / 96, nb = j % 96;
      float* sc = (float*)smem;
      for (int idx = tid; idx < 9 * 1024; idx += 256) {
        int ci = idx >> 10, k = idx & 1023;
        float v = ci == 0 ? pin(p, 6)[k] : pin(p, 2)[(ci - 1) * 1024 + k];
        sc[idx] = siluf_(v);
      }
      __syncthreads();
      int kg = tid >> 6, n = nb * 64 + (tid & 63);
      float a[9];
#pragma unroll
      for (int ci = 0; ci < 9; ++ci) a[ci] = 0.f;
      const float* W = pin(p, 7) + (long)l * 1024 * 6144 + n;
#pragma unroll 4
      for (int k = kg * 256; k < kg * 256 + 256; ++k) {
        float w = W[(long)k * 6144];
#pragma unroll
        for (int ci = 0; ci < 9; ++ci) a[ci] += sc[ci * 1024 + k] * w;
      }
      __syncthreads();
      float* red = (float*)smem;
#pragma unroll
      for (int ci = 0; ci < 9; ++ci) red[(kg * 9 + ci) * 64 + (tid & 63)] = a[ci];
      __syncthreads();
      for (int idx = tid; idx < 9 * 64; idx += 256) {
        int ci = idx >> 6, nn = idx & 63;
        float s = red[(0 * 9 + ci) * 64 + nn] + red[(1 * 9 + ci) * 64 + nn] + red[(2 * 9 + ci) * 64 + nn] + red[(3 * 9 + ci) * 64 + nn];
        int ncol = nb * 64 + nn;
        ((float*)(lws(p) + WS_MOD))[(l * 9 + ci) * 6144 + ncol] = s + pin(p, 8)[l * 6144 + ncol];
      }
      __syncthreads();
    } else {
      int j = it - total - n_fold - n_mod;
      int idx = j * 256 + tid;
      if (idx < 128 * 64) {
        int r = idx >> 6, n = idx & 63;
        float v = (r < 64) ? cos_rev(((r * n) & 63) * (1.f / 64.f)) : -sin_rev((((r - 64) * n) & 63) * (1.f / 64.f));
        ((u16*)(lws(p) + WS_D1))[idx] = f2bf(v);
      } else {
        int e = idx - 128 * 64;
        int r = e >> 7, kk = e & 127;
        int k2 = r & 63, ro = r >> 6, n2 = kk & 63, ri = kk >> 6;
        float fr_ = ((k2 * n2) & 63) * (1.f / 64.f);
        float v;
        if (ro == 0) v = ri == 0 ? cos_rev(fr_) : sin_rev(fr_);
        else v = ri == 0 ? -sin_rev(fr_) : cos_rev(fr_);
        ((u16*)(lws(p) + WS_D2))[e] = f2bf(v);
      }
    }
  }
}

__device__ __forceinline__ float4 load_x4(const Params& p, bool from_input, int t, int c4) {
  if (from_input) return ((const float4*)x_in_row(p, 0, t))[c4];
  uint2 w = *(const uint2*)((const u16*)lout(p) + (long)t * 1024 + c4 * 4);
  return float4{bflo(w.x), bfhi(w.x), bflo(w.y), bfhi(w.y)};
}
__device__ __forceinline__ void phase_norm(const Params& p, int layer, int which, bool x_from_input, bool store_xb = false) {
  const int lane = ltid() & 63;
  const int wg = lbid() * 4 + __builtin_amdgcn_readfirstlane(ltid() >> 6), nw = gridDim.x * 4;
  const float* g = pin(p, which ? 24 : 9) + layer * 1024;
  u16* H = (u16*)(lws(p) + WS_H);
  constexpr int RB = 4;
  const int rpw = ((T_ALL + nw - 1) / nw + RB - 1) / RB * RB;
  int ci_prev = -1;
  float4 G[2][2], SH[2][2];
  for (int k = 0; k < rpw; k += RB) {
    const int t0 = wg * rpw + k;
    if (t0 >= T_ALL) break;
    int tr[RB];
#pragma unroll
    for (int q = 0; q < RB; ++q) tr[q] = which ? (T_ALL - 1 - (t0 + q)) : (t0 + q);
    const int ci = cond_index(tr[0]);
    if (ci != ci_prev) {
      ci_prev = ci;
      const float* mod = (const float*)(lws(p) + WS_MOD) + (layer * 9 + ci) * 6144 + which * 3072;
#pragma unroll
      for (int i = 0; i < 2; ++i)
#pragma unroll
        for (int h2 = 0; h2 < 2; ++h2) {
          int c4 = (lane + 64 * i) * 2 + h2;
          float4 gg = ((const float4*)g)[c4];
          float4 sc = ((const float4*)(mod + 1024))[c4];
          SH[i][h2] = ((const float4*)mod)[c4];
          G[i][h2] = float4{gg.x * (1.f + sc.x), gg.y * (1.f + sc.y), gg.z * (1.f + sc.z), gg.w * (1.f + sc.w)};
        }
    }
    float4 v[RB][2][2];
    float ss[RB];
#pragma unroll
    for (int q = 0; q < RB; ++q) {
      const int t = tr[q];
#pragma unroll
      for (int i = 0; i < 2; ++i) {
        const int c8 = lane + 64 * i;
        if (x_from_input) {
          const float4* xr = (const float4*)x_in_row(p, 0, t);
          v[q][i][0] = ld_nt4((const float*)(xr + c8 * 2));
          v[q][i][1] = ld_nt4((const float*)(xr + c8 * 2 + 1));
        } else {
          u32x4 w = *(const u32x4*)((const u16*)lout(p) + (long)t * 1024 + c8 * 8);
          v[q][i][0] = float4{bflo(w[0]), bfhi(w[0]), bflo(w[1]), bfhi(w[1])};
          v[q][i][1] = float4{bflo(w[2]), bfhi(w[2]), bflo(w[3]), bfhi(w[3])};
        }
      }
    }
#pragma unroll
    for (int q = 0; q < RB; ++q) {
      float a = 0.f;
#pragma unroll
      for (int i = 0; i < 2; ++i)
#pragma unroll
        for (int h2 = 0; h2 < 2; ++h2) a += v[q][i][h2].x * v[q][i][h2].x + v[q][i][h2].y * v[q][i][h2].y + v[q][i][h2].z * v[q][i][h2].z + v[q][i][h2].w * v[q][i][h2].w;
      ss[q] = a;
    }
#pragma unroll
    for (int o = 32; o > 0; o >>= 1)
#pragma unroll
      for (int q = 0; q < RB; ++q) ss[q] += __shfl_xor(ss[q], o);
#pragma unroll
    for (int q = 0; q < RB; ++q) {
      const float r = rsqrtf(ss[q] * (1.f / 1024.f) + 1e-6f);
#pragma unroll
      for (int i = 0; i < 2; ++i) {
        u32x4 o4;
#pragma unroll
        for (int h2 = 0; h2 < 2; ++h2) {
          float4 x4 = v[q][i][h2], gg = G[i][h2], sh = SH[i][h2];
          o4[2 * h2] = pk2(x4.x * r * gg.x + sh.x, x4.y * r * gg.y + sh.y);
          o4[2 * h2 + 1] = pk2(x4.z * r * gg.z + sh.z, x4.w * r * gg.w + sh.w);
        }
        *(u32x4*)(H + (long)tr[q] * 1024 + (lane + 64 * i) * 8) = o4;
      }
    }
  }
}

__device__ __forceinline__ void phase_in_gemm(const Params& p, int layer, unsigned char* smem) {
  const int tid = ltid(), wid = __builtin_amdgcn_readfirstlane(tid >> 6), lane = tid & 63, wr = wid >> 1, wc = wid & 1, fr = lane & 15, fq = lane >> 4;
  const u16* H = (const u16*)(lws(p) + WS_H);
  const u16* W = (const u16*)(lwt(p, layer) + WT_IN1);
  u16* Zo = (u16*)(lws(p) + WS_Z1);
  const int nN = Z1 / 128, ntiles = (T_ALL / 128) * nN;
  bool pf = false;
  for (int t = lbid(); t < ntiles; t += gridDim.x) {
    int pm, pn, pmn = 0, pnn = 0;
    tile_map_n12(t, pm, pn);
    const int tn = t + gridDim.x;
    const bool hn = tn < ntiles;
    if (hn) tile_map_n12(tn, pmn, pnn);
    f32x4 acc[4][4];
    zero_acc(acc);
    gemm_acc(acc, H + (long)pm * 128 * 1024, 1024, W + (long)pn * 128 * 1024, 1024, 1024, smem, true, pf,
             hn ? H + (long)pmn * 128 * 1024 : nullptr, 1024, W + (long)pnn * 128 * 1024, 1024);
    pf = hn;
#pragma unroll
    for (int m = 0; m < 4; ++m)
#pragma unroll
      for (int n = 0; n < 4; n += 2) {
        int tok = pm * 128 + wr * 64 + m * 16 + fr, col = pn * 128 + wc * 64 + n * 16;
        uint2 a = uint2{pk2(acc[m][n][0], acc[m][n][1]), pk2(acc[m][n][2], acc[m][n][3])};
        uint2 b = uint2{pk2(acc[m][n + 1][0], acc[m][n + 1][1]), pk2(acc[m][n + 1][2], acc[m][n + 1][3])};
        store_pair16(Zo + (long)tok * Z1 + col, a, b, fq);
      }
  }
}

__device__ __forceinline__ float logsig(float x) { return fminf(x, 0.f) - __logf(1.f + __expf(-fabsf(x))); }

__device__ __forceinline__ void gla_prep(const Params& p, int layer, int t0, int hh, float* laf, float* lab, float* wa, float* ba) {
  const int tid = ltid();
  for (int idx = tid; idx < 1024; idx += 256) {
    int dir = idx >> 9, r = (idx >> 5) & 15, d = idx & 31;
    wa[idx] = pin(p, dir ? 17 : 15)[layer * 2048 + r * 128 + hh * 32 + d];
  }
  if (tid < 64) {
    int dir = tid >> 5, d = tid & 31;
    ba[tid] = pin(p, dir ? 18 : 16)[layer * 128 + hh * 32 + d];
  }
  __syncthreads();
  {
    int i = tid >> 2, d0 = (tid & 3) * 8;
    const u16* zr = (const u16*)(lws(p) + WS_Z1) + (long)(t0 + i) * Z1;
    uint4 a0 = *(const uint4*)(zr + 1440), a1 = *(const uint4*)(zr + 1448);
    uint4 b0 = *(const uint4*)(zr + 1456), b1 = *(const uint4*)(zr + 1464);
    unsigned aw[8] = {a0.x, a0.y, a0.z, a0.w, a1.x, a1.y, a1.z, a1.w};
    unsigned bw[8] = {b0.x, b0.y, b0.z, b0.w, b1.x, b1.y, b1.z, b1.w};
#pragma unroll 1
    for (int e = 0; e < 8; ++e) {
      int d = d0 + e;
      float xf = ba[d], xb = ba[32 + d];
#pragma unroll
      for (int r = 0; r < 8; ++r) {
        xf += bflo(aw[r]) * wa[(2 * r) * 32 + d] + bfhi(aw[r]) * wa[(2 * r + 1) * 32 + d];
        xb += bflo(bw[r]) * wa[512 + (2 * r) * 32 + d] + bfhi(bw[r]) * wa[512 + (2 * r + 1) * 32 + d];
      }
      laf[i * 32 + d] = logsig(xf) * (1.f / 16.f);
      lab[i * 32 + d] = logsig(xb) * (1.f / 16.f);
    }
  }
  __syncthreads();
  {
    const int seg = tid >> 6, dir = (tid >> 5) & 1, d = tid & 31;
    float* arr = dir ? lab : laf;
    float* segtot = wa;
    float run = 0.f;
    if (dir == 0) {
#pragma unroll 4
      for (int i = seg * 16; i < seg * 16 + 16; ++i) { run += arr[i * 32 + d]; arr[i * 32 + d] = run; }
    } else {
#pragma unroll 4
      for (int i = seg * 16 + 15; i >= seg * 16; --i) { run += arr[i * 32 + d]; arr[i * 32 + d] = run; }
    }
    __syncthreads();
    segtot[(dir * 4 + seg) * 32 + d] = run;
    __syncthreads();
    float off = 0.f;
    if (dir == 0) { for (int s2 = 0; s2 < seg; ++s2) off += segtot[(0 * 4 + s2) * 32 + d]; }
    else { for (int s2 = seg + 1; s2 < 4; ++s2) off += segtot[(1 * 4 + s2) * 32 + d]; }
#pragma unroll 4
    for (int i = seg * 16; i < seg * 16 + 16; ++i) arr[i * 32 + d] += off;
  }
  __syncthreads();
}

__device__ __forceinline__ void gla_local(const Params& p, int layer, int item, unsigned char* smem) {
  const int tid = ltid(), wid = __builtin_amdgcn_readfirstlane(tid >> 6), lane = tid & 63, fr = lane & 15, fq = lane >> 4;
  const int ci = item >> 2, hh = item & 3, t0 = ci * 64;
  float* laf = (float*)smem;
  float* lab = laf + 2048;
  float* wa = lab + 2048;
  float* ba = wa + 1024;
  u16* khf = (u16*)(smem + 20736);
  u16* khb = khf + 32 * 72;
  u16* vt = khb + 32 * 72;
  gla_prep(p, layer, t0, hh, laf, lab, wa, ba);
  {
    int i = tid >> 2, d0 = (tid & 3) * 8;
    const u16* zr = (const u16*)(lws(p) + WS_Z1) + (long)(t0 + i) * Z1;
    uint4 kq = *(const uint4*)(zr + 800 + hh * 32 + d0);
    unsigned kw[4] = {kq.x, kq.y, kq.z, kq.w};
#pragma unroll
    for (int e = 0; e < 8; ++e) {
      int d = d0 + e;
      float kv = (e & 1) ? bfhi(kw[e >> 1]) : bflo(kw[e >> 1]);
      khf[d * 72 + i] = f2bf(kv * __expf(laf[63 * 32 + d] - laf[i * 32 + d]));
      khb[d * 72 + i] = f2bf(kv * __expf(lab[d] - lab[i * 32 + d]));
    }
    int e0 = (tid & 3) * 16;
    uint4 v0 = *(const uint4*)(zr + 928 + hh * 64 + e0), v1 = *(const uint4*)(zr + 928 + hh * 64 + e0 + 8);
    unsigned vw[8] = {v0.x, v0.y, v0.z, v0.w, v1.x, v1.y, v1.z, v1.w};
#pragma unroll
    for (int e = 0; e < 16; ++e) vt[(e0 + e) * 72 + i] = (u16)((e & 1) ? (vw[e >> 1] >> 16) : (vw[e >> 1] & 0xffffu));
  }
  float* dec = (float*)(lws(p) + WS_GDEC) + (long)item * 64;
  if (tid < 32) dec[tid] = __expf(laf[63 * 32 + tid]);
  else if (tid < 64) dec[tid] = __expf(lab[tid - 32]);
  __syncthreads();
  u16* dS = (u16*)(lws(p) + WS_GDS) + (long)item * 2 * 2048;
#pragma unroll
  for (int dir = 0; dir < 2; ++dir) {
    const u16* kh = dir ? khb : khf;
#pragma unroll
    for (int dt = 0; dt < 2; ++dt) {
      f32x4 acc = {0.f, 0.f, 0.f, 0.f};
#pragma unroll
      for (int kk = 0; kk < 2; ++kk) {
        bf16x8 a = *(const bf16x8*)(vt + (wid * 16 + fr) * 72 + kk * 32 + fq * 8);
        bf16x8 b = *(const bf16x8*)(kh + (dt * 16 + fr) * 72 + kk * 32 + fq * 8);
        acc = __builtin_amdgcn_mfma_f32_16x16x32_bf16(a, b, acc, 0, 0, 0);
      }
#pragma unroll
      for (int j = 0; j < 4; ++j) dS[dir * 2048 + (wid * 16 + fq * 4 + j) * 32 + dt * 16 + fr] = f2bf(acc[j]);
    }
  }
  __syncthreads();
}

__device__ __forceinline__ void gla_scan_block(const Params& p, int layer, int blk) {
  const int tid = ltid();
  int seq = blk >> 3, elem = (blk & 7) * 256 + tid;
  int e = elem >> 5, d = elem & 31;
  int b, hh, dir, c0, n;
  bool prompt = seq < 256;
  if (prompt) { b = seq >> 3; hh = (seq >> 1) & 3; dir = seq & 1; c0 = b * 4; n = 4; }
  else { int s = seq - 256; b = s >> 3; hh = (s >> 1) & 3; dir = s & 1; c0 = 128 + b * 64; n = 64; }
  const u16* dS = (const u16*)(lws(p) + WS_GDS);
  u16* SS = (u16*)(lws(p) + WS_GSS);
  const float* dec = (const float*)(lws(p) + WS_GDEC);
  float S = 0.f;
  if (!prompt) S = pin(p, 5)[((((long)(b * 2 + layer) * 2 + dir) * 4 + hh) * 32 + d) * 64 + e];
  if (prompt) {
    float ds[4], dc[4];
    long sl[4];
#pragma unroll
    for (int c = 0; c < 4; ++c) {
      int ci = dir ? (c0 + 3 - c) : (c0 + c);
      sl[c] = ((long)(ci * 4 + hh) * 2 + dir);
      ds[c] = bf2f(dS[sl[c] * 2048 + elem]);
      dc[c] = dec[sl[c] * 32 + d];
    }
#pragma unroll
    for (int c = 0; c < 4; ++c) { SS[sl[c] * 2048 + elem] = f2bf(S); S = dc[c] * S + ds[c]; }
  } else {
#pragma unroll 1
    for (int cb = 0; cb < 64; cb += 16) {
      float ds[16], dc[16];
#pragma unroll
      for (int c = 0; c < 16; ++c) {
        int ci = dir ? (c0 + 63 - (cb + c)) : (c0 + cb + c);
        long slot = ((long)(ci * 4 + hh) * 2 + dir);
        ds[c] = bf2f(dS[slot * 2048 + elem]);
        dc[c] = dec[slot * 32 + d];
      }
#pragma unroll
      for (int c = 0; c < 16; ++c) {
        int ci = dir ? (c0 + 63 - (cb + c)) : (c0 + cb + c);
        long slot = ((long)(ci * 4 + hh) * 2 + dir);
        SS[slot * 2048 + elem] = f2bf(S);
        S = dc[c] * S + ds[c];
      }
    }
  }
  if (prompt) lout(p)[OUT_ST + ((((long)(b * 2 + layer) * 2 + dir) * 4 + hh) * 32 + d) * 64 + e] = S;
}

__device__ __forceinline__ void gla_output(const Params& p, int layer, int item, unsigned char* smem) {
  const int tid = ltid(), wid = __builtin_amdgcn_readfirstlane(tid >> 6), lane = tid & 63, fr = lane & 15, fq = lane >> 4;
  const int ci = item >> 2, hh = item & 3, t0 = ci * 64;
  float* laf = (float*)smem;
  float* lab = laf + 2048;
  u16* P = (u16*)smem;
  float* wa = (float*)(smem + 18432);
  float* ba = wa + 1024;
  u16* qf = (u16*)(smem + 18432 + 4352);
  u16* kf = qf + 64 * 40;
  u16* qb = kf + 64 * 40;
  u16* kb = qb + 64 * 40;
  u16* vt = kb + 64 * 40;
  gla_prep(p, layer, t0, hh, laf, lab, wa, ba);
  {
    int i = tid >> 2, d0 = (tid & 3) * 8;
    const u16* zr = (const u16*)(lws(p) + WS_Z1) + (long)(t0 + i) * Z1;
    uint4 qq = *(const uint4*)(zr + 672 + hh * 32 + d0);
    uint4 kq = *(const uint4*)(zr + 800 + hh * 32 + d0);
    unsigned qw[4] = {qq.x, qq.y, qq.z, qq.w}, kw[4] = {kq.x, kq.y, kq.z, kq.w};
    const float sc = 0.17677669529663687f;
    unsigned oqf[4], okf[4], oqb[4], okb[4];
#pragma unroll
    for (int e2 = 0; e2 < 4; ++e2) {
      int d = d0 + e2 * 2;
      float q0 = bflo(qw[e2]) * sc, q1 = bfhi(qw[e2]) * sc, k0 = bflo(kw[e2]), k1 = bfhi(kw[e2]);
      float f0 = laf[i * 32 + d], f1 = laf[i * 32 + d + 1], b0 = lab[i * 32 + d], b1 = lab[i * 32 + d + 1];
      oqf[e2] = pk2(q0 * __expf(f0), q1 * __expf(f1));
      okf[e2] = pk2(k0 * __expf(-f0), k1 * __expf(-f1));
      oqb[e2] = pk2(q0 * __expf(b0), q1 * __expf(b1));
      okb[e2] = pk2(k0 * __expf(-b0), k1 * __expf(-b1));
    }
    *(uint4*)(qf + i * 40 + d0) = uint4{oqf[0], oqf[1], oqf[2], oqf[3]};
    *(uint4*)(kf + i * 40 + d0) = uint4{okf[0], okf[1], okf[2], okf[3]};
    *(uint4*)(qb + i * 40 + d0) = uint4{oqb[0], oqb[1], oqb[2], oqb[3]};
    *(uint4*)(kb + i * 40 + d0) = uint4{okb[0], okb[1], okb[2], okb[3]};
    int e0 = (tid & 3) * 16;
    uint4 v0 = *(const uint4*)(zr + 928 + hh * 64 + e0), v1 = *(const uint4*)(zr + 928 + hh * 64 + e0 + 8);
    unsigned vw[8] = {v0.x, v0.y, v0.z, v0.w, v1.x, v1.y, v1.z, v1.w};
#pragma unroll
    for (int e = 0; e < 16; ++e) vt[(e0 + e) * 72 + i] = (u16)((e & 1) ? (vw[e >> 1] >> 16) : (vw[e >> 1] & 0xffffu));
  }
  __syncthreads();
  f32x4 o[4];
#pragma unroll
  for (int et = 0; et < 4; ++et) o[et] = f32x4{0.f, 0.f, 0.f, 0.f};
  const u16* SS = (const u16*)(lws(p) + WS_GSS) + (long)item * 2 * 2048;
#pragma unroll
  for (int dir = 0; dir < 2; ++dir) {
    const u16* qd = dir ? qb : qf;
    const u16* kd = dir ? kb : kf;
    u16* Pd = P + dir * 64 * 72;
    bf16x8 qfrag = *(const bf16x8*)(qd + (wid * 16 + fr) * 40 + fq * 8);
#pragma unroll
    for (int jt = 0; jt < 4; ++jt) {
      bf16x8 kfrag = *(const bf16x8*)(kd + (jt * 16 + fr) * 40 + fq * 8);
      f32x4 s = {0.f, 0.f, 0.f, 0.f};
      s = __builtin_amdgcn_mfma_f32_16x16x32_bf16(kfrag, qfrag, s, 0, 0, 0);
      int i = wid * 16 + fr;
      float pv[4];
#pragma unroll
      for (int r = 0; r < 4; ++r) {
        int j = jt * 16 + fq * 4 + r;
        bool keep = dir ? (j >= i) : (j <= i);
        pv[r] = keep ? s[r] : 0.f;
      }
      uint2 o2;
      o2.x = pk2(pv[0], pv[1]);
      o2.y = pk2(pv[2], pv[3]);
      *(uint2*)(Pd + i * 72 + jt * 16 + fq * 4) = o2;
    }
#pragma unroll
    for (int kk = 0; kk < 2; ++kk) {
      bf16x8 pfrag = *(const bf16x8*)(Pd + (wid * 16 + fr) * 72 + kk * 32 + fq * 8);
#pragma unroll
      for (int et = 0; et < 4; ++et) {
        bf16x8 vfrag = *(const bf16x8*)(vt + (et * 16 + fr) * 72 + kk * 32 + fq * 8);
        o[et] = __builtin_amdgcn_mfma_f32_16x16x32_bf16(vfrag, pfrag, o[et], 0, 0, 0);
      }
    }
#pragma unroll
    for (int et = 0; et < 4; ++et) {
      bf16x8 sfrag = *(const bf16x8*)(SS + dir * 2048 + (et * 16 + fr) * 32 + fq * 8);
      o[et] = __builtin_amdgcn_mfma_f32_16x16x32_bf16(sfrag, qfrag, o[et], 0, 0, 0);
    }
  }
  float ss = 0.f;
#pragma unroll
  for (int et = 0; et < 4; ++et)
#pragma unroll
    for (int r = 0; r < 4; ++r) ss += o[et][r] * o[et][r];
  ss += __shfl_xor(ss, 16);
  ss += __shfl_xor(ss, 32);
  float rn = rsqrtf(ss * (1.f / 64.f) + 1e-6f);
  {
    int i = wid * 16 + fr;
    const u16* zr = (const u16*)(lws(p) + WS_Z1) + (long)(t0 + i) * Z1 + 1184 + hh * 64;
    u16* og = (u16*)(lws(p) + WS_OG) + (long)(t0 + i) * 256 + hh * 64;
    const float* gn = pin(p, 19) + layer * 256 + hh * 64;
#pragma unroll
    for (int et = 0; et < 4; ++et) {
      int e = et * 16 + fq * 4;
      uint2 gr = *(const uint2*)(zr + e);
      float4 g4 = *(const float4*)(gn + e);
      float r0 = o[et][0] * rn * g4.x * siluf_(bflo(gr.x));
      float r1 = o[et][1] * rn * g4.y * siluf_(bfhi(gr.x));
      float r2 = o[et][2] * rn * g4.z * siluf_(bflo(gr.y));
      float r3 = o[et][3] * rn * g4.w * siluf_(bfhi(gr.y));
      uint2 o2;
      o2.x = pk2(r0, r1);
      o2.y = pk2(r2, r3);
      *(uint2*)(og + e) = o2;
    }
  }
  __syncthreads();
}

template <int NT>
__device__ __forceinline__ void latent_prep_tokens(const Params& p, int layer, int t0, int lane) {
  u16* z = (u16*)(lws(p) + WS_Z1);
  const int e = lane & 31;
  uint2 wq[NT];
  unsigned wk[NT];
  float vr[NT];
#pragma unroll
  for (int k = 0; k < NT; ++k) {
    const u16* zr = z + (long)(t0 + k) * Z1;
    wq[k] = *(const uint2*)(zr + 256 + lane * 4);
    wk[k] = *(const unsigned*)(zr + 512 + lane * 2);
    vr[k] = bf2f(zr[640 + e]);
  }
  const float4 gq = *(const float4*)(pin(p, 11) + layer * 256 + lane * 4);
  const float2 gk = *(const float2*)(pin(p, 12) + layer * 128 + lane * 2);
  float sq[NT], sk[NT];
#pragma unroll
  for (int k = 0; k < NT; ++k) {
    float v0 = bflo(wq[k].x), v1 = bfhi(wq[k].x), v2 = bflo(wq[k].y), v3 = bfhi(wq[k].y);
    sq[k] = v0 * v0 + v1 * v1 + v2 * v2 + v3 * v3;
    float c0 = bflo(wk[k]), c1 = bfhi(wk[k]);
    sk[k] = c0 * c0 + c1 * c1;
  }
#pragma unroll
  for (int o = 32; o > 0; o >>= 1)
#pragma unroll
    for (int k = 0; k < NT; ++k) { sq[k] += __shfl_xor(sq[k], o); sk[k] += __shfl_xor(sk[k], o); }
#pragma unroll
  for (int k = 0; k < NT; ++k) {
    const int t = t0 + k;
    u16* zr = z + (long)t * Z1;
    {
      float r = rsqrtf(sq[k] * (1.f / 256.f) + 1e-6f);
      uint2 o2;
      o2.x = pk2(bflo(wq[k].x) * r * gq.x, bfhi(wq[k].x) * r * gq.y);
      o2.y = pk2(bflo(wq[k].y) * r * gq.z, bfhi(wq[k].y) * r * gq.w);
      *(uint2*)(zr + 256 + lane * 4) = o2;
    }
    const bool prompt = t < T_P;
    int b, pos, kt;
    if (prompt) { b = t >> 8; pos = t & 255; kt = t; }
    else { int s_ = t - T_P; b = s_ >> 12; pos = s_ & 4095; kt = T_P + b * 4608 + 512 + pos; }
    {
      float r = rsqrtf(sk[k] * (1.f / 128.f) + 1e-6f);
      float c0 = bflo(wk[k]) * r * gk.x, c1 = bfhi(wk[k]) * r * gk.y;
      *(unsigned*)((u16*)(lws(p) + WS_CKV) + (long)kt * 128 + lane * 2) = pk2(c0, c1);
      if (prompt) *(float2*)(lout(p) + OUT_CKV + ((long)(b * 2 + layer) * 256 + pos) * 128 + lane * 2) = float2{c0, c1};
    }
    {
      float v = vr[k];
      float other = __shfl_xor(v, 8);
      float res = v;
      if (!prompt) {
        int part = e >> 4, idx = e & 15, fi = idx & 7;
        int ps = part ? (pos & 63) : (pos >> 6);
        float inv = exp2f(-(float)fi * 1.6609640474436813f);
        float rev = (float)ps * inv * 0.15915494309189535f;
        rev -= floorf(rev);
        float cs = cos_rev(rev), sn = sin_rev(rev);
        res = ((e & 15) < 8) ? (v * cs - other * sn) : (other * sn + v * cs);
      }
      if (lane < 32) {
        ((u16*)(lws(p) + WS_KR))[(long)kt * 32 + e] = f2bf(res);
        if (prompt) lout(p)[OUT_KR + ((long)(b * 2 + layer) * 256 + pos) * 32 + e] = v;
      }
    }
  }
}

__device__ __forceinline__ void cache_convert_row(const Params& p, int layer, int row, int lane) {
  int b = row >> 9, j = row & 511;
  long kt = T_P + (long)b * 4608 + j;
  const float* src = pin(p, 3) + ((long)(b * 2 + layer) * 512 + j) * 128;
  float2 v = *(const float2*)(src + lane * 2);
  *(unsigned*)((u16*)(lws(p) + WS_CKV) + kt * 128 + lane * 2) = pk2(v.x, v.y);
  if (lane < 32) {
    const float* s2 = pin(p, 4) + ((long)(b * 2 + layer) * 512 + j) * 32;
    ((u16*)(lws(p) + WS_KR))[kt * 32 + lane] = f2bf(s2[lane]);
  }
}

template <int K>
__device__ __forceinline__ void fourier_mma(f32x4 (&acc)[8][2], const u16* Dm, const u16* XT, int wid, int fr, int fq) {
  constexpr int KP = K + 8;
#pragma unroll
  for (int rt = 0; rt < 8; ++rt)
#pragma unroll
    for (int ct = 0; ct < 2; ++ct) acc[rt][ct] = f32x4{0.f, 0.f, 0.f, 0.f};
#pragma unroll 1
  for (int kk = 0; kk < K / 32; ++kk) {
    bf16x8 xf[2];
#pragma unroll
    for (int ct = 0; ct < 2; ++ct) xf[ct] = *(const bf16x8*)(XT + ((wid * 2 + ct) * 16 + fr) * KP + kk * 32 + fq * 8);
#pragma unroll
    for (int rt = 0; rt < 8; ++rt) {
      bf16x8 df = *(const bf16x8*)(Dm + (rt * 16 + fr) * K + kk * 32 + fq * 8);
#pragma unroll
      for (int ct = 0; ct < 2; ++ct) acc[rt][ct] = __builtin_amdgcn_mfma_f32_16x16x32_bf16(xf[ct], df, acc[rt][ct], 0, 0, 0);
    }
  }
}

__device__ __forceinline__ void fourier_p1(const Params& p, int item, unsigned char* smem) {
  const int tid = ltid(), wid = __builtin_amdgcn_readfirstlane(tid >> 6), lane = tid & 63, fr = lane & 15, fq = lane >> 4;
  const int chalf = item & 1, n2 = (item >> 1) & 63, b = item >> 7;
  u16* XT = (u16*)smem;
  const u16* z = (const u16*)(lws(p) + WS_Z1);
  {
    int n1 = tid & 63;
    long tok = T_P + (long)b * 4096 + 64 * n1 + n2;
#pragma unroll
    for (int it = 0; it < 4; ++it) {
      int chunk = it * 4 + (tid >> 6);
      uint4 v = *(const uint4*)(z + tok * Z1 + chalf * 128 + chunk * 8);
      unsigned w[4] = {v.x, v.y, v.z, v.w};
#pragma unroll
      for (int e = 0; e < 8; ++e) XT[(chunk * 8 + e) * 72 + n1] = (u16)((e & 1) ? (w[e >> 1] >> 16) : (w[e >> 1] & 0xffffu));
    }
  }
  __syncthreads();
  f32x4 acc[8][2];
  fourier_mma<64>(acc, (const u16*)(lws(p) + WS_D1), XT, wid, fr, fq);
  u16* VP = (u16*)(lws(p) + WS_VP);
#pragma unroll
  for (int rt = 0; rt < 4; ++rt) {
    int k1 = rt * 16 + fr;
    float frac = (float)((k1 * n2) & 4095) * (1.f / 4096.f);
    float cs = cos_rev(frac), sn = sin_rev(frac);
#pragma unroll
    for (int ct = 0; ct < 2; ++ct) {
      int c = chalf * 128 + (wid * 2 + ct) * 16 + fq * 4;
      float vr[4], vi[4];
#pragma unroll
      for (int j = 0; j < 4; ++j) {
        float a = acc[rt][ct][j], bb = acc[rt + 4][ct][j];
        vr[j] = cs * a + sn * bb;
        vi[j] = cs * bb - sn * a;
      }
      long base = (((long)(b * 64 + n2) * 64 + k1) * 2) * 256;
      *(uint2*)(VP + base + c) = uint2{pk2(vr[0], vr[1]), pk2(vr[2], vr[3])};
      *(uint2*)(VP + base + 256 + c) = uint2{pk2(vi[0], vi[1]), pk2(vi[2], vi[3])};
    }
  }
  __syncthreads();
}

__device__ __forceinline__ void fourier_p2(const Params& p, int item, unsigned char* smem) {
  const int tid = ltid(), wid = __builtin_amdgcn_readfirstlane(tid >> 6), lane = tid & 63, fr = lane & 15, fq = lane >> 4;
  u16* XT = (u16*)smem;
  const bool sample = item < 1024;
  int chalf, k1, b, R;
  long tokbase;
  float nrm;
  if (sample) {
    chalf = item & 1; k1 = (item >> 1) & 63; b = item >> 7; R = 64; tokbase = T_P + (long)b * 4096; nrm = 1.f / 512.f;
    const u16* VP = (const u16*)(lws(p) + WS_VP);
    int kk = tid & 127;
    int ri = kk >> 6, n2 = kk & 63;
    const u16* src = VP + (((long)(b * 64 + n2) * 64 + k1) * 2 + ri) * 256 + chalf * 128;
#pragma unroll
    for (int it = 0; it < 8; ++it) {
      int chunk = it * 2 + (tid >> 7);
      uint4 v = *(const uint4*)(src + chunk * 8);
      unsigned w[4] = {v.x, v.y, v.z, v.w};
#pragma unroll
      for (int e = 0; e < 8; ++e) XT[(chunk * 8 + e) * 136 + kk] = (u16)((e & 1) ? (w[e >> 1] >> 16) : (w[e >> 1] & 0xffffu));
    }
  } else {
    int j = item - 1024;
    chalf = j & 1; k1 = (j >> 1) & 3; b = j >> 3; R = 4; tokbase = (long)b * 256; nrm = 1.f / 128.f;
    const u16* z = (const u16*)(lws(p) + WS_Z1);
    int n2 = tid & 63;
    float frac = (float)((k1 * n2) & 255) * (1.f / 256.f);
    float cs = cos_rev(frac), sn = sin_rev(frac);
#pragma unroll
    for (int it = 0; it < 4; ++it) {
      int chunk = it * 4 + (tid >> 6);
      float vr[8], vi[8];
#pragma unroll
      for (int e = 0; e < 8; ++e) { vr[e] = 0.f; vi[e] = 0.f; }
#pragma unroll
      for (int n1 = 0; n1 < 4; ++n1) {
        uint4 v = *(const uint4*)(z + (tokbase + 64 * n1 + n2) * Z1 + chalf * 128 + chunk * 8);
        unsigned w[4] = {v.x, v.y, v.z, v.w};
        int ee = (k1 * n1) & 3;
        float wre = (ee == 0) ? 1.f : (ee == 2 ? -1.f : 0.f);
        float wim = (ee == 1) ? -1.f : (ee == 3 ? 1.f : 0.f);
#pragma unroll
        for (int e = 0; e < 8; ++e) {
          float x = (e & 1) ? bfhi(w[e >> 1]) : bflo(w[e >> 1]);
          vr[e] += wre * x;
          vi[e] += wim * x;
        }
      }
#pragma unroll
      for (int e = 0; e < 8; ++e) {
        XT[(chunk * 8 + e) * 136 + n2] = f2bf(cs * vr[e] + sn * vi[e]);
        XT[(chunk * 8 + e) * 136 + 64 + n2] = f2bf(cs * vi[e] - sn * vr[e]);
      }
    }
  }
  __syncthreads();
  f32x4 acc[8][2];
  fourier_mma<128>(acc, (const u16*)(lws(p) + WS_D2), XT, wid, fr, fq);
  u16* F = (u16*)(lws(p) + WS_F);
#pragma unroll
  for (int rt = 0; rt < 8; ++rt) {
    int r = rt * 16 + fr, ro = r >> 6, k2 = r & 63;
    long tok = tokbase + k1 + R * k2;
#pragma unroll
    for (int ct = 0; ct < 2; ++ct) {
      int c = chalf * 128 + (wid * 2 + ct) * 16 + fq * 4;
      int fcol = (c >> 6) * 128 + ro * 64 + (c & 63);
      *(uint2*)(F + tok * 512 + fcol) = uint2{pk2(acc[rt][ct][0] * nrm, acc[rt][ct][1] * nrm), pk2(acc[rt][ct][2] * nrm, acc[rt][ct][3] * nrm)};
    }
  }
  __syncthreads();
}

__device__ __forceinline__ void qup_tile(const Params& p, int layer, int t, unsigned char* smem) {
  const int tid = ltid(), wid = __builtin_amdgcn_readfirstlane(tid >> 6), lane = tid & 63, wr = wid >> 1, wc = wid & 1, fr = lane & 15, fq = lane >> 4;
  const int pm = ((t >> 3) / 6) * 8 + (t & 7), pn = (t >> 3) % 6;
  f32x4 acc[4][4];
  zero_acc(acc);
  gemm_acc(acc, (const u16*)(lws(p) + WS_Z1) + (long)pm * 128 * Z1 + 256, Z1, (const u16*)(lwt(p, layer) + WT_QUP) + (long)pn * 128 * 256, 256, 256, smem, true);
  u16* Q = (u16*)lout(p) + Q_OFS;
  const float qs = 0.10206207261596577f * 1.4426950408889634f;
#pragma unroll
  for (int m = 0; m < 4; ++m) {
    int tok = pm * 128 + wr * 64 + m * 16 + fr;
    bool smp = tok >= T_P;
    int pos = (tok - T_P) & 4095;
    uint2 o2[4];
#pragma unroll
    for (int n = 0; n < 4; ++n) {
      int col0 = pn * 128 + wc * 64 + n * 16;
      int dd0 = col0 % 96;
      float v[4];
#pragma unroll
      for (int j = 0; j < 4; ++j) v[j] = acc[m][n][j];
      if (dd0 >= 64) {
        int part = (dd0 - 64) >> 4;
        int ps = part ? (pos & 63) : (pos >> 6);
#pragma unroll
        for (int j = 0; j < 4; ++j) {
          float other = __shfl_xor(v[j], 32);
          int fi = (fq & 1) * 4 + j;
          float inv = exp2f(-(float)fi * 1.6609640474436813f);
          float rev = (float)ps * inv * 0.15915494309189535f;
          rev -= floorf(rev);
          float cs = cos_rev(rev), sn = sin_rev(rev);
          float res = (fq < 2) ? (v[j] * cs - other * sn) : (other * sn + v[j] * cs);
          if (smp) v[j] = res;
        }
      }
      o2[n] = uint2{pk2(v[0] * qs, v[1] * qs), pk2(v[2] * qs, v[3] * qs)};
    }
#pragma unroll
    for (int n = 0; n < 4; n += 2) store_pair16(Q + (long)tok * 768 + pn * 128 + wc * 64 + n * 16, o2[n], o2[n + 1], fq);
  }
}

__device__ __forceinline__ long vt_base(int kt, int& Lk, int& key) {
  if (kt < T_P) { int b = kt >> 8; Lk = 256; key = kt & 255; return (long)b * 512 * 256; }
  int s = kt - T_P; int b = s / 4608; Lk = 4608; key = s - b * 4608; return (long)T_P * 512 + (long)b * 512 * 4608;
}

__device__ __forceinline__ void kvup_tile(const Params& p, int layer, int t, unsigned char* smem) {
  const int tid = ltid(), wid = __builtin_amdgcn_readfirstlane(tid >> 6), lane = tid & 63, wr = wid >> 1, wc = wid & 1, fr = lane & 15, fq = lane >> 4;
  const int pm = ((t >> 6) << 3) + (t & 7), pn = (t >> 3) & 7;
  f32x4 acc[4][4];
  zero_acc(acc);
  gemm_acc(acc, (const u16*)(lws(p) + WS_CKV) + (long)pm * 128 * 128, 128, (const u16*)(lwt(p, layer) + WT_KVUP) + (long)pn * 128 * 128, 128, 128, smem, wc == 0);
  if (wc == 0) {
    u16* KN = (u16*)(lws(p) + WS_KNOPE);
#pragma unroll
    for (int m = 0; m < 4; ++m)
#pragma unroll
      for (int n = 0; n < 4; n += 2) {
        int kt = pm * 128 + wr * 64 + m * 16 + fr;
        store_pair16(KN + (long)kt * 512 + pn * 64 + n * 16, uint2{pk2(acc[m][n][0], acc[m][n][1]), pk2(acc[m][n][2], acc[m][n][3])},
                     uint2{pk2(acc[m][n + 1][0], acc[m][n + 1][1]), pk2(acc[m][n + 1][2], acc[m][n + 1][3])}, fq);
      }
  } else {
    u16* VT = (u16*)(lws(p) + WS_VT);
#pragma unroll
    for (int m = 0; m < 4; m += 2) {
      int kt = pm * 128 + wr * 64 + m * 16;
      int Lk, key;
      long base = vt_base(kt, Lk, key);
#pragma unroll
      for (int n = 0; n < 4; ++n) {
        int dv = n * 16 + fr;
        store_pair16(VT + base + (long)(pn * 64 + dv) * Lk + key, uint2{pk2(acc[m][n][0], acc[m][n][1]), pk2(acc[m][n][2], acc[m][n][3])},
                     uint2{pk2(acc[m + 1][n][0], acc[m + 1][n][1]), pk2(acc[m + 1][n][2], acc[m + 1][n][3])}, fq);
      }
    }
  }
}

constexpr int ATT_KB = 64 * 208;
constexpr int ATT_STAGE = ATT_KB + 64 * 144;
__device__ __forceinline__ void attn_stage(const u16* KNh, const u16* KR, const u16* VTb, long key0, int koff, int Lk, unsigned char* buf, int tid) {
#pragma unroll
  for (int i = 0; i < 4; ++i) {
    int s = i * 256 + tid;
    if (s < 832) {
      int row = s / 13, cs = s - row * 13;
      const u16* src = (cs < 8) ? (KNh + (key0 + row) * 512 + cs * 8) : ((cs < 12) ? (KR + (key0 + row) * 32 + (cs - 8) * 8) : (KNh + (key0 + row) * 512));
      glds16(src, buf + s * 16);
    }
  }
#pragma unroll
  for (int i = 0; i < 3; ++i) {
    int s = i * 256 + tid;
    if (s < 576) {
      int row = s / 9, cs = s - row * 9;
      const u16* src = VTb + (long)row * Lk + koff + ((cs < 8) ? cs * 8 : 0);
      glds16(src, buf + ATT_KB + s * 16);
    }
  }
}

__device__ __forceinline__ void attn_item(const Params& p, int idx, unsigned char* smem) {
  const int tid = ltid(), wid = __builtin_amdgcn_readfirstlane(tid >> 6), lane = tid & 63, r = lane & 31, hf = lane >> 5;
  const int rp = (r & 0x13) | ((r & 4) << 1) | ((r & 8) >> 1);
  int h, Lk;
  long q0, kt0, vtb;
  if (idx < 1024) {
    const int q_ = idx >> 3;
    int b = q_ >> 4, qb = q_ & 15;
    h = idx & 7;
    q0 = T_P + (long)b * 4096 + qb * 256;
    kt0 = T_P + (long)b * 4608;
    Lk = 4608;
    vtb = (long)T_P * 512 + (long)b * 512 * 4608 + (long)h * 64 * 4608;
  } else {
    int j = idx - 1024;
    int b = j >> 3;
    h = j & 7;
    q0 = (long)b * 256;
    kt0 = (long)b * 256;
    Lk = 256;
    vtb = (long)b * 512 * 256 + (long)h * 64 * 256;
  }
  const u16* Q = (const u16*)lout(p) + Q_OFS;
  const u16* KNh = (const u16*)(lws(p) + WS_KNOPE) + h * 64;
  const u16* KR = (const u16*)(lws(p) + WS_KR);
  const u16* VT = (const u16*)(lws(p) + WS_VT) + vtb;
  const long qtok = q0 + wid * 64 + r;
  bf16x8 qf[2][6];
#pragma unroll
  for (int qi = 0; qi < 2; ++qi)
#pragma unroll
    for (int s = 0; s < 6; ++s) qf[qi][s] = *(const bf16x8*)(Q + (qtok + qi * 32) * 768 + h * 96 + 16 * s + 8 * hf);
  f32x16 o[2][2];
#pragma unroll
  for (int qi = 0; qi < 2; ++qi)
#pragma unroll
    for (int vt = 0; vt < 2; ++vt)
#pragma unroll
      for (int i = 0; i < 16; ++i) o[qi][vt][i] = 0.f;
  float mrun[2] = {0.f, 0.f}, lsum[2] = {0.f, 0.f};
  bool first = true, shifted = false;
  const int nst = Lk >> 6;
  attn_stage(KNh, KR, VT, kt0, 0, Lk, smem, tid);
  for (int t = 0; t < nst; ++t) {
    asm volatile("s_waitcnt vmcnt(0)" ::: "memory");
    __syncthreads();
    if (t + 1 < nst) attn_stage(KNh, KR, VT, kt0 + (t + 1) * 64, (t + 1) * 64, Lk, smem + ((t + 1) & 1) * ATT_STAGE, tid);
    const unsigned char* kb = smem + (t & 1) * ATT_STAGE;
    const unsigned char* vb = kb + ATT_KB;
#pragma unroll 1
    for (int u = 0; u < 2; ++u) {
      f32x16 st[2];
      if (!shifted) {
#pragma unroll
        for (int qi = 0; qi < 2; ++qi)
#pragma unroll
          for (int i = 0; i < 16; ++i) st[qi][i] = 0.f;
#pragma unroll
        for (int s = 0; s < 6; ++s) {
          bf16x8 kf = *(const bf16x8*)(kb + (u * 32 + rp) * 208 + (2 * s + hf) * 16);
          st[0] = __builtin_amdgcn_mfma_f32_32x32x16_bf16(kf, qf[0][s], st[0], 0, 0, 0);
          st[1] = __builtin_amdgcn_mfma_f32_32x32x16_bf16(kf, qf[1][s], st[1], 0, 0, 0);
        }
      } else {
#pragma unroll
        for (int qi = 0; qi < 2; ++qi)
#pragma unroll
          for (int i = 0; i < 16; ++i) st[qi][i] = -mrun[qi];
#pragma unroll
        for (int s = 0; s < 6; ++s) {
          bf16x8 kf = *(const bf16x8*)(kb + (u * 32 + rp) * 208 + (2 * s + hf) * 16);
          st[0] = __builtin_amdgcn_mfma_f32_32x32x16_bf16(kf, qf[0][s], st[0], 0, 0, 0);
          st[1] = __builtin_amdgcn_mfma_f32_32x32x16_bf16(kf, qf[1][s], st[1], 0, 0, 0);
        }
      }
      float mx[2];
#pragma unroll
      for (int qi = 0; qi < 2; ++qi) {
        float m = st[qi][0];
#pragma unroll
        for (int i = 1; i < 16; ++i) m = fmaxf(m, st[qi][i]);
        mx[qi] = xhalf_max(m);
      }
      if (__any((int)((mx[0] > 64.f) | (mx[1] > 64.f) | (first & ((mx[0] < -64.f) | (mx[1] < -64.f)))))) {
        shifted = true;
#pragma unroll
        for (int qi = 0; qi < 2; ++qi) {
          float mxc = first ? mx[qi] : fmaxf(mx[qi], 0.f);
          float alpha = __builtin_amdgcn_exp2f(-mxc);
          mrun[qi] += mxc;
          lsum[qi] *= alpha;
#pragma unroll
          for (int i = 0; i < 16; ++i) { st[qi][i] -= mxc; o[qi][0][i] *= alpha; o[qi][1][i] *= alpha; }
        }
      }
      first = false;
      bf16x8 pf[2][2];
#pragma unroll
      for (int qi = 0; qi < 2; ++qi) {
        float ps = 0.f;
#pragma unroll
        for (int i = 0; i < 16; ++i) { st[qi][i] = __builtin_amdgcn_exp2f(st[qi][i]); ps += st[qi][i]; }
        lsum[qi] += ps;
#pragma unroll
        for (int s = 0; s < 2; ++s) {
          u32x4 pw;
#pragma unroll
          for (int j2 = 0; j2 < 4; ++j2) pw[j2] = pk2(st[qi][8 * s + 2 * j2], st[qi][8 * s + 2 * j2 + 1]);
          pf[qi][s] = __builtin_bit_cast(bf16x8, pw);
        }
      }
#pragma unroll
      for (int s = 0; s < 2; ++s) {
        const int kofs = (u * 32 + 16 * s + 8 * hf) * 2;
#pragma unroll
        for (int vt = 0; vt < 2; ++vt) {
          bf16x8 vf = *(const bf16x8*)(vb + (32 * vt + r) * 144 + kofs);
          o[0][vt] = __builtin_amdgcn_mfma_f32_32x32x16_bf16(vf, pf[0][s], o[0][vt], 0, 0, 0);
          o[1][vt] = __builtin_amdgcn_mfma_f32_32x32x16_bf16(vf, pf[1][s], o[1][vt], 0, 0, 0);
        }
      }
    }
  }
  __syncthreads();
#pragma unroll
  for (int qi = 0; qi < 2; ++qi) {
    float ltot = lsum[qi] + __shfl_xor(lsum[qi], 32);
    float inv = 1.f / ltot;
    u16* AT = (u16*)(lws(p) + WS_ATT) + (qtok + qi * 32) * 512 + h * 64;
#pragma unroll
    for (int g = 0; g < 4; ++g) {
      int dv = 8 * g + 4 * hf;
      *(uint2*)(AT + dv) = uint2{pk2(o[qi][0][4 * g] * inv, o[qi][0][4 * g + 1] * inv), pk2(o[qi][0][4 * g + 2] * inv, o[qi][0][4 * g + 3] * inv)};
      *(uint2*)(AT + 32 + dv) = uint2{pk2(o[qi][1][4 * g] * inv, o[qi][1][4 * g + 1] * inv), pk2(o[qi][1][4 * g + 2] * inv, o[qi][1][4 * g + 3] * inv)};
    }
  }
}

__device__ __forceinline__ void merge_step(const Params& p, int layer, int t, int idx, const u16*& A, const u16*& W, int& K) {
  int pm, pn;
  tile_map_n8(t, pm, pn);
  const int br = idx >> 1;
  unsigned char* ws = lws(p);
  unsigned char* wt = lwt(p, layer);
  if ((idx & 1) == 0) { A = (const u16*)(ws + WS_H) + (long)pm * 128 * 1024; W = (const u16*)(wt + WT_GATE) + (long)(br * 1024 + pn * 128) * 1024; K = 1024; }
  else if (br == 0) { A = (const u16*)(ws + WS_F) + (long)pm * 128 * 512; W = (const u16*)(wt + WT_OF) + (long)pn * 128 * 512; K = 512; }
  else if (br == 1) { A = (const u16*)(ws + WS_ATT) + (long)pm * 128 * 512; W = (const u16*)(wt + WT_OMLA) + (long)pn * 128 * 512; K = 512; }
  else { A = (const u16*)(ws + WS_OG) + (long)pm * 128 * 256; W = (const u16*)(wt + WT_OGLA) + (long)pn * 128 * 256; K = 256; }
}

__device__ __forceinline__ void merge_tile(const Params& p, int layer, int t, int tn, bool pf, unsigned char* smem) {
  const int tid = ltid(), wid = __builtin_amdgcn_readfirstlane(tid >> 6), lane = tid & 63, wr = wid >> 1, wc = wid & 1, fr = lane & 15, fq = lane >> 4;
  int pm, pn;
  tile_map_n8(t, pm, pn);
  unsigned mg[4][4][2];
#pragma unroll
  for (int m = 0; m < 4; ++m)
#pragma unroll
    for (int n = 0; n < 4; ++n) { mg[m][n][0] = 0u; mg[m][n][1] = 0u; }
#pragma unroll 1
  for (int br = 0; br < 3; ++br) {
    unsigned gp[4][4][2];
    const u16 *A0, *W0, *A1, *W1, *A2, *W2;
    int K0, K1, K2;
    merge_step(p, layer, t, br * 2, A0, W0, K0);
    merge_step(p, layer, t, br * 2 + 1, A1, W1, K1);
    {
      f32x4 g[4][4];
      zero_acc(g);
      gemm_acc<2>(g, A0, K0, W0, K0, K0, smem, true, pf || br > 0, A1, K1, W1, K1);
#pragma unroll
      for (int m = 0; m < 4; ++m)
#pragma unroll
        for (int n = 0; n < 4; ++n) {
          gp[m][n][0] = pk2(sigmoidf_(g[m][n][0]), sigmoidf_(g[m][n][1]));
          gp[m][n][1] = pk2(sigmoidf_(g[m][n][2]), sigmoidf_(g[m][n][3]));
        }
    }
    f32x4 y[4][4];
    zero_acc(y);
    bool hasn = true;
    if (br < 2) merge_step(p, layer, t, br * 2 + 2, A2, W2, K2);
    else if (tn >= 0) merge_step(p, layer, tn, 0, A2, W2, K2);
    else { hasn = false; A2 = nullptr; W2 = nullptr; K2 = 0; }
    gemm_acc<2>(y, A1, K1, W1, K1, K1, smem, true, true, hasn ? A2 : nullptr, K2, W2, K2);
#pragma unroll
    for (int m = 0; m < 4; ++m)
#pragma unroll
      for (int n = 0; n < 4; ++n) {
        float r0 = bflo(mg[m][n][0]) + bflo(gp[m][n][0]) * y[m][n][0];
        float r1 = bfhi(mg[m][n][0]) + bfhi(gp[m][n][0]) * y[m][n][1];
        float r2 = bflo(mg[m][n][1]) + bflo(gp[m][n][1]) * y[m][n][2];
        float r3 = bfhi(mg[m][n][1]) + bfhi(gp[m][n][1]) * y[m][n][3];
        mg[m][n][0] = pk2(r0, r1);
        mg[m][n][1] = pk2(r2, r3);
      }
  }
  u16* MG = (u16*)(lws(p) + WS_MERGED);
#pragma unroll
  for (int m = 0; m < 4; ++m)
#pragma unroll
    for (int n = 0; n < 4; n += 2) {
      int tok = pm * 128 + wr * 64 + m * 16 + fr, col = pn * 128 + wc * 64 + n * 16;
      store_pair16(MG + (long)tok * 1024 + col, uint2{mg[m][n][0], mg[m][n][1]}, uint2{mg[m][n + 1][0], mg[m][n + 1][1]}, fq);
    }
}

__device__ __forceinline__ void resid_tile(const Params& p, int layer, int pm, int pn, const u16* A, int K, const u16* W, int gate_ofs, bool x_from_input, unsigned char* smem,
                                           int tn, bool pf, bool rev = false, bool to_h = false) {
  const int tid = ltid(), wid = __builtin_amdgcn_readfirstlane(tid >> 6), lane = tid & 63, wr = wid >> 1, wc = wid & 1, fr = lane & 15, fq = lane >> 4;
  f32x4 acc[4][4];
  zero_acc(acc);
  int pmn = 0, pnn = 0;
  if (tn >= 0) { tile_map_n8(tn, pmn, pnn); if (rev) pmn = 319 - pmn; }
  gemm_acc(acc, A + (long)pm * 128 * K, K, W + (long)pn * 128 * K, K, K, smem, true, pf,
           tn >= 0 ? A + (long)pmn * 128 * K : nullptr, K, W + (long)pnn * 128 * K, K);
  const float* mod = (const float*)(lws(p) + WS_MOD) + (layer * 9 + cond_index(pm * 128)) * 6144 + gate_ofs;
  float4 gv[4];
#pragma unroll
  for (int n = 0; n < 4; ++n) gv[n] = *(const float4*)(mod + pn * 128 + wc * 64 + n * 16 + fq * 4);
  const int lofs = ((fq & 1) << 4) + ((fq >> 1) << 3);
#pragma unroll
  for (int m = 0; m < 4; ++m) {
    int tok = pm * 128 + wr * 64 + m * 16 + fr;
    u16* xdst = (to_h ? (u16*)(lws(p) + WS_H) : (u16*)lout(p)) + (long)tok * 1024;
    uint2 o2[4];
    if (x_from_input) {
#pragma unroll
      for (int n = 0; n < 4; ++n) {
        int col = pn * 128 + wc * 64 + n * 16 + fq * 4;
        float4 xv = ((const float4*)x_in_row(p, 0, tok))[col >> 2];
        o2[n].x = pk2(xv.x + gv[n].x * acc[m][n][0], xv.y + gv[n].y * acc[m][n][1]);
        o2[n].y = pk2(xv.z + gv[n].z * acc[m][n][2], xv.w + gv[n].w * acc[m][n][3]);
      }
    } else {
      const u16* xsrc = (const u16*)lout(p) + (long)tok * 1024;
#pragma unroll
      for (int n = 0; n < 4; n += 2) {
        u32x4 w = *(const u32x4*)(xsrc + pn * 128 + wc * 64 + n * 16 + lofs);
        auto rx = __builtin_amdgcn_permlane16_swap(w[0], w[2], false, false);
        auto ry = __builtin_amdgcn_permlane16_swap(w[1], w[3], false, false);
        const unsigned ax = rx[0], bx = rx[1], ay = ry[0], by = ry[1];
        o2[n].x = pk2(bflo(ax) + gv[n].x * acc[m][n][0], bfhi(ax) + gv[n].y * acc[m][n][1]);
        o2[n].y = pk2(bflo(ay) + gv[n].z * acc[m][n][2], bfhi(ay) + gv[n].w * acc[m][n][3]);
        o2[n + 1].x = pk2(bflo(bx) + gv[n + 1].x * acc[m][n + 1][0], bfhi(bx) + gv[n + 1].y * acc[m][n + 1][1]);
        o2[n + 1].y = pk2(bflo(by) + gv[n + 1].z * acc[m][n + 1][2], bfhi(by) + gv[n + 1].w * acc[m][n + 1][3]);
      }
    }
#pragma unroll
    for (int n = 0; n < 4; n += 2) store_pair16(xdst + pn * 128 + wc * 64 + n * 16, o2[n], o2[n + 1], fq);
  }
}

__device__ __forceinline__ void ff1_tile(const Params& p, int layer, int t, int tn, bool pf, unsigned char* smem) {
  const int tid = ltid(), wid = __builtin_amdgcn_readfirstlane(tid >> 6), lane = tid & 63, wr = wid >> 1, wc = wid & 1, fr = lane & 15, fq = lane >> 4;
  int pm, pn, pmn = 0, pnn = 0;
  tile_map_n32(t, pm, pn);
  if (tn >= 0) tile_map_n32(tn, pmn, pnn);
  f32x4 acc[4][4];
  zero_acc(acc);
  const u16* Hb = (const u16*)(lws(p) + WS_H);
  const u16* Wb = (const u16*)(lwt(p, layer) + WT_FF1);
  gemm_acc(acc, Hb + (long)(pm * 128) * 1024, 1024, Wb + (long)pn * 128 * 1024, 1024, 1024, smem, true, pf,
           tn >= 0 ? Hb + (long)(pmn * 128) * 1024 : nullptr, 1024, Wb + (long)pnn * 128 * 1024, 1024);
  u16* U = (u16*)(lws(p) + WS_U);
#pragma unroll
  for (int m = 0; m < 4; ++m)
#pragma unroll
    for (int n = 0; n < 4; n += 2) {
      int row = pm * 128 + wr * 64 + m * 16 + fr, col = pn * 128 + wc * 64 + n * 16;
      uint2 ab[2];
#pragma unroll
      for (int h2 = 0; h2 < 2; ++h2) {
        float v[4];
#pragma unroll
        for (int j = 0; j < 4; ++j) { float a = fmaxf(acc[m][n + h2][j], 0.f); v[j] = a * a; }
        ab[h2] = uint2{pk2(v[0], v[1]), pk2(v[2], v[3])};
      }
      store_pair16_nt(U + (long)row * 4096 + col, ab[0], ab[1], fq);
    }
}

__device__ __forceinline__ void phase_final_norm(const Params& p) {
  const int lane = ltid() & 63;
  const int wg = lbid() * 4 + __builtin_amdgcn_readfirstlane(ltid() >> 6), nw = gridDim.x * 4;
  const float* g = pin(p, 27);
  constexpr int RB = 4;
  const int rpw = ((T_ALL + nw - 1) / nw + RB - 1) / RB * RB;
  float4 G[2][2];
#pragma unroll
  for (int i = 0; i < 2; ++i)
#pragma unroll
    for (int h2 = 0; h2 < 2; ++h2) G[i][h2] = ((const float4*)g)[(lane + 64 * i) * 2 + h2];
  for (int k = 0; k < rpw; k += RB) {
    const int t0 = wg * rpw + k;
    if (t0 >= T_ALL) break;
    float4 v[RB][2][2];
    float ss[RB];
#pragma unroll
    for (int q = 0; q < RB; ++q) {
      const u16* xs = (const u16*)(lws(p) + WS_H) + (long)(t0 + q) * 1024;
      float a = 0.f;
#pragma unroll
      for (int i = 0; i < 2; ++i) {
        u32x4 w = *(const u32x4*)(xs + (lane + 64 * i) * 8);
        v[q][i][0] = float4{bflo(w[0]), bfhi(w[0]), bflo(w[1]), bfhi(w[1])};
        v[q][i][1] = float4{bflo(w[2]), bfhi(w[2]), bflo(w[3]), bfhi(w[3])};
#pragma unroll
        for (int h2 = 0; h2 < 2; ++h2) a += v[q][i][h2].x * v[q][i][h2].x + v[q][i][h2].y * v[q][i][h2].y + v[q][i][h2].z * v[q][i][h2].z + v[q][i][h2].w * v[q][i][h2].w;
      }
      ss[q] = a;
    }
#pragma unroll
    for (int o = 32; o > 0; o >>= 1)
#pragma unroll
      for (int q = 0; q < RB; ++q) ss[q] += __shfl_xor(ss[q], o);
#pragma unroll
    for (int q = 0; q < RB; ++q) {
      const float r = rsqrtf(ss[q] * (1.f / 1024.f) + 1e-6f);
      float* x = lout(p) + (long)(t0 + q) * 1024;
#pragma unroll
      for (int i = 0; i < 2; ++i)
#pragma unroll
        for (int h2 = 0; h2 < 2; ++h2) {
          float4 x4 = v[q][i][h2], gg = G[i][h2];
          st_nt4(x + ((lane + 64 * i) * 2 + h2) * 4, float4{x4.x * r * gg.x, x4.y * r * gg.y, x4.z * r * gg.z, x4.w * r * gg.w});
        }
    }
  }
}

__device__ __forceinline__ void run_phase(const Params& p, int ph, unsigned char* smem) {
  if (ph == 2 * NPH_LAYER) { phase_final_norm(p); return; }
  const int layer = ph / NPH_LAYER, lp = ph % NPH_LAYER;
  const int lane = ltid() & 63;
  switch (lp) {
    case 0: phase_prep(p, layer, smem);
      break;
    case 1: phase_norm(p, layer, 0, layer == 0);
      break;
    case 2: phase_in_gemm(p, layer, smem); break;
    case 3: {
      const int n0 = 2560, n1 = 1024, n2 = T_ALL / 16, n3 = 4096 / 4;
      int it = lbid();
      for (; it < n0; it += gridDim.x) gla_local(p, layer, it, smem);
      for (; it < n0 + n1; it += gridDim.x) fourier_p1(p, it - n0, smem);
      for (; it < n0 + n1 + n2; it += gridDim.x) latent_prep_tokens<4>(p, layer, (it - n0 - n1) * 16 + __builtin_amdgcn_readfirstlane(ltid() >> 6) * 4, lane);
      for (; it < n0 + n1 + n2 + n3; it += gridDim.x) cache_convert_row(p, layer, (it - n0 - n1 - n2) * 4 + __builtin_amdgcn_readfirstlane(ltid() >> 6), lane);
    } break;
    case 4: {
      const int n0 = 2816, n1 = 1920, n2 = 1280, n3 = 2560;
      int it = lbid();
      for (; it < n0; it += gridDim.x) kvup_tile(p, layer, it, smem);
      for (; it < n0 + n1; it += gridDim.x) qup_tile(p, layer, it - n0, smem);
      for (; it < n0 + n1 + n2; it += gridDim.x) fourier_p2(p, it - n0 - n1, smem);
      for (; it < n0 + n1 + n2 + n3; it += gridDim.x) gla_scan_block(p, layer, it - n0 - n1 - n2);
    } break;
    case 5: {
      const int n0 = 1280, n1 = 2560;
      if (layer == 0 && ((lbid() >> 8) & 1) == 0) phase_prep(p, 1, smem);
      int it = lbid();
      for (; it < n0; it += gridDim.x) attn_item(p, it, smem);
      for (; it < n0 + n1; it += gridDim.x) gla_output(p, layer, it - n0, smem);
      if (layer == 0 && ((lbid() >> 8) & 1) == 1) phase_prep(p, 1, smem);
    } break;
    case 6: phase_norm(p, layer, 0, layer == 0); break;
    case 7:
      {
        bool pf = false;
        for (int t = lbid(); t < 320 * 8; t += gridDim.x) {
          int tn = t + gridDim.x;
          if (tn >= 320 * 8) tn = -1;
          merge_tile(p, layer, t, tn, pf, smem);
          pf = tn >= 0;
        }
      }
      break;
    case 8:
      {
        bool pf = false;
        for (int t = lbid(); t < 320 * 8; t += gridDim.x) {
          int tn = t + gridDim.x;
          if (tn >= 320 * 8) tn = -1;
          int pm, pn;
          tile_map_n8(t, pm, pn);
          resid_tile(p, layer, pm, pn, (const u16*)(lws(p) + WS_MERGED), 1024, (const u16*)(lwt(p, layer) + WT_OUT), 2048, layer == 0, smem, tn, pf);
          pf = tn >= 0;
        }
      }
      break;
    case 9: phase_norm(p, layer, 1, false); break;
    case 10:
      {
        bool pf = false;
        for (int t = lbid(); t < 320 * 32; t += gridDim.x) {
          int tn = t + gridDim.x;
          if (tn >= 320 * 32) tn = -1;
          ff1_tile(p, layer, t, tn, pf, smem);
          pf = tn >= 0;
        }
      }
      break;
    case 11:
      {
        bool pf = false;
        for (int t = lbid(); t < 320 * 8; t += gridDim.x) {
          int tn = t + gridDim.x;
          if (tn >= 320 * 8) tn = -1;
          int pm, pn;
          tile_map_n8(t, pm, pn);
          pm = 319 - pm;
          resid_tile(p, layer, pm, pn, (const u16*)(lws(p) + WS_U), 4096, (const u16*)(lwt(p, layer) + WT_FF2), 5120, false, smem, tn, pf, true, layer == 1);
          pf = tn >= 0;
        }
      }
      break;
  }
}

#if !MULTI_LAUNCH
__global__ void __launch_bounds__(256, 2) fwd_megakernel(Params p) {
  __shared__ __attribute__((aligned(16))) unsigned char smem[65536];
  cg::grid_group grid = cg::this_grid();
  if (p.ph_lo == 0x7fffffff) grid.sync();
  XcdBarrier xb = xcd_barrier_post((unsigned*)(p.ws + WS_BAR));
#if LAUNDER && !defined(UNROLL_PH)
#pragma unroll 1
  for (int ph = 0; ph < NPHASES; ++ph) {
    run_phase(p, ph, smem);
    if (ph + 1 < NPHASES) xcd_barrier(xb);
  }
#else
#define RP(ph) run_phase(p, ph, smem); xcd_barrier(xb);
  RP(0) RP(1) RP(2) RP(3) RP(4) RP(5) RP(7) RP(8) RP(9) RP(10) RP(11)
  RP(13) RP(14) RP(15) RP(16) RP(17) RP(19) RP(20) RP(21) RP(22) RP(23)
  run_phase(p, 24, smem);
#endif
}

#else
__global__ void __launch_bounds__(256, 2) fwd_phase_kernel(Params p) {
  __shared__ __attribute__((aligned(16))) unsigned char smem[65536];
  run_phase(p, p.ph_lo, smem);
}
#endif

extern "C" void kernel_launch(void* const* d_in, const int* in_sizes, int n_in, void* d_out, int out_size, void* d_ws, size_t ws_size, hipStream_t stream) {
  static int grid_blocks = 0;
  if (!grid_blocks) {
    if (n_in != 28 || ws_size < WS_END) { fprintf(stderr, "kernel_launch: bad n_in %d or ws %zu < %zu\n", n_in, ws_size, (size_t)WS_END); grid_blocks = -1; return; }
    int dev = 0, cus = 0, per_cu = 0;
    (void)hipGetDevice(&dev);
    (void)hipDeviceGetAttribute(&cus, hipDeviceAttributeMultiprocessorCount, dev);
#if MULTI_LAUNCH
    (void)hipOccupancyMaxActiveBlocksPerMultiprocessor(&per_cu, fwd_phase_kernel, 256, 0);
#else
    (void)hipOccupancyMaxActiveBlocksPerMultiprocessor(&per_cu, fwd_megakernel, 256, 0);
#endif
    if (per_cu > 2) per_cu = 2;
    if (per_cu < 1) per_cu = 1;
    grid_blocks = cus * per_cu;
  }
  if (grid_blocks < 0) return;
  Params p{};
  for (int i = 0; i < 28; ++i) p.in[i] = (const float*)d_in[i];
  p.out = (float*)d_out;
  p.ws = (unsigned char*)d_ws;
#if MULTI_LAUNCH
  for (int ph = 0; ph < NPHASES; ++ph) {
    p.ph_lo = ph; p.ph_hi = ph + 1;
    hipLaunchKernelGGL(fwd_phase_kernel, dim3(grid_blocks), dim3(256), 0, stream, p);
  }
#else
  p.ph_lo = 0; p.ph_hi = NPHASES;
  (void)hipMemsetAsync((unsigned char*)d_ws + WS_BAR, 0, 16384, stream);
  void* args[] = {&p};
  hipError_t e = hipLaunchCooperativeKernel((void*)fwd_megakernel, dim3(grid_blocks), dim3(256), args, 0, stream);
  if (e != hipSuccess) fprintf(stderr, "cooperative launch failed: %s (grid %d)\n", hipGetErrorString(e), grid_blocks);
#endif
}
```

```cpp
#include <hip/hip_runtime.h>
#include <hip/hip_cooperative_groups.h>
#include <stdint.h>
#include <stdio.h>
namespace cg = cooperative_groups;

typedef unsigned short u16;
typedef __attribute__((ext_vector_type(8))) short bf16x8;
typedef __attribute__((ext_vector_type(4))) float f32x4;
typedef __attribute__((ext_vector_type(16))) float f32x16;
typedef __attribute__((ext_vector_type(4))) unsigned u32x4;

#ifndef MULTI_LAUNCH
#define MULTI_LAUNCH 0
#endif

constexpr int T_ALL = 40960, T_P = 8192;
constexpr int KT_ALL = 45056;
constexpr int Z1 = 1536;
constexpr int NPH_LAYER = 12;
constexpr int NPHASES = 2 * NPH_LAYER + 1;

constexpr long OUT_CKV = 41943040L, OUT_KR = 44040192L, OUT_ST = 44564480L;

constexpr size_t WT_IN1 = 0;
constexpr size_t WT_GATE = WT_IN1 + 1536ul * 1024 * 2;
constexpr size_t WT_QUP = WT_GATE + 3072ul * 1024 * 2;
constexpr size_t WT_KVUP = WT_QUP + 768ul * 256 * 2;
constexpr size_t WT_OF = WT_KVUP + 1024ul * 128 * 2;
constexpr size_t WT_OMLA = WT_OF + 1024ul * 512 * 2;
constexpr size_t WT_OGLA = WT_OMLA + 1024ul * 512 * 2;
constexpr size_t WT_OUT = WT_OGLA + 1024ul * 256 * 2;
constexpr size_t WT_FF1 = WT_OUT + 1024ul * 1024 * 2;
constexpr size_t WT_FF2 = WT_FF1 + 4096ul * 1024 * 2;
constexpr size_t WT_TOTAL = WT_FF2 + 1024ul * 4096 * 2;
constexpr size_t WS_MOD = 2 * WT_TOTAL;
constexpr size_t WS_D1 = WS_MOD + 2ul * 9 * 6144 * 4;
constexpr size_t WS_D2 = WS_D1 + 128ul * 64 * 2;
constexpr size_t WS_H = WS_D2 + 128ul * 128 * 2;
constexpr size_t WS_RA = WS_H + 40960ul * 1024 * 2;
constexpr size_t WS_Z1 = WS_RA;
constexpr size_t WS_KNOPE = WS_Z1 + 40960ul * 1536 * 2;
constexpr size_t WS_VT = WS_KNOPE + 45056ul * 512 * 2;
constexpr size_t WS_GDS = WS_VT + 45056ul * 512 * 2;
constexpr size_t WS_GSS = WS_GDS + 2560ul * 2 * 2048 * 2;
constexpr size_t WS_GDEC = WS_GSS + 2560ul * 2 * 2048 * 2;
constexpr size_t WS_RC = WS_GDEC + 2560ul * 2 * 32 * 4;
constexpr size_t WS_F = WS_RC;
constexpr size_t WS_ATT = WS_F + 40960ul * 512 * 2;
constexpr size_t WS_OG = WS_ATT + 40960ul * 512 * 2;
constexpr size_t WS_CKV = WS_OG + 40960ul * 256 * 2;
constexpr size_t WS_KR = WS_CKV + 45056ul * 128 * 2;
constexpr size_t WS_BAR = WS_KR + 45056ul * 32 * 2;
constexpr size_t WS_END = WS_BAR + 16384;
static_assert(40960ul * 4096 * 2 <= (WS_BAR - WS_RA), "u fits");
constexpr size_t WS_U = WS_RA;
constexpr size_t WS_MERGED = WS_Z1;
constexpr long Q_OFS = 40960L * 1024;
constexpr size_t WS_VP = WS_ATT;

struct Params {
  const float* in[28];
  float* out;
  unsigned char* ws;
  int ph_lo, ph_hi;
};

#ifndef LAUNDER
#define LAUNDER 1
#endif
#define UNROLL_PH 1
#if LAUNDER
__device__ __forceinline__ int opq_s() { int z; asm volatile("s_mov_b32 %0, 0" : "=s"(z)); return z; }
__device__ __forceinline__ int opq_v() { int z; asm volatile("v_mov_b32 %0, 0" : "=v"(z)); return z; }
#else
__device__ __forceinline__ int opq_s() { return 0; }
__device__ __forceinline__ int opq_v() { return 0; }
#endif
__device__ __forceinline__ int ltid() { return (int)threadIdx.x + opq_v(); }
__device__ __forceinline__ int lbid() { return (int)blockIdx.x + opq_s(); }
__device__ __forceinline__ unsigned char* lws(const Params& p) { return p.ws + opq_s(); }
__device__ __forceinline__ float* lout(const Params& p) { return p.out + opq_s(); }
__device__ __forceinline__ unsigned char* lwt(const Params& p, int layer) { return p.ws + opq_s() + (size_t)layer * WT_TOTAL; }
__device__ __forceinline__ const float* pin(const Params& p, int i) { return p.in[i + opq_s()]; }
__device__ __forceinline__ u16 f2bf(float f) { return __builtin_bit_cast(u16, (__bf16)f); }
__device__ __forceinline__ float bf2f(u16 h) { return __uint_as_float(((unsigned)h) << 16); }
typedef __bf16 bf16x2_t __attribute__((ext_vector_type(2)));
typedef float f32x2_t __attribute__((ext_vector_type(2)));
__device__ __forceinline__ unsigned pk2(float a, float b) { f32x2_t v = {a, b}; bf16x2_t r = __builtin_convertvector(v, bf16x2_t); return __builtin_bit_cast(unsigned, r); }
__device__ __forceinline__ float bflo(unsigned w) { return __uint_as_float(w << 16); }
__device__ __forceinline__ float bfhi(unsigned w) { return __uint_as_float(w & 0xffff0000u); }
__device__ __forceinline__ float4 ld_nt4(const float* p) { f32x4 t = __builtin_nontemporal_load((const f32x4*)p); return float4{t[0], t[1], t[2], t[3]}; }
__device__ __forceinline__ void st_nt4(float* p, float4 v) { __builtin_nontemporal_store(f32x4{v.x, v.y, v.z, v.w}, (f32x4*)p); }
__device__ __forceinline__ float cos_rev(float r) { return __builtin_amdgcn_cosf(r); }
__device__ __forceinline__ float sin_rev(float r) { return __builtin_amdgcn_sinf(r); }
__device__ __forceinline__ float xhalf_max(float m) {
  auto r = __builtin_amdgcn_permlane32_swap(__float_as_uint(m), __float_as_uint(m), false, false);
  return fmaxf(__uint_as_float(r[0]), __uint_as_float(r[1]));
}
__device__ __forceinline__ float sigmoidf_(float x) { return __builtin_amdgcn_rcpf(1.f + __builtin_amdgcn_exp2f(-1.4426950408889634f * x)); }
__device__ __forceinline__ float siluf_(float x) { return x * __builtin_amdgcn_rcpf(1.f + __builtin_amdgcn_exp2f(-1.4426950408889634f * x)); }

__device__ __forceinline__ void glds16(const void* g, void* l) {
  __builtin_amdgcn_global_load_lds((const unsigned*)g, (unsigned*)l, 16, 0, 0);
}


#define XB_TMO      128
#define XB_XCNT(j)  (256  + 64 * (j))
#define XB_XSUB(j)  (1280 + 64 * (j))
#define XB_XGEN(j)  (2304 + 64 * (j))
#define XB_TOP      3328
#define XB_TOPGEN   3392
#define XCD_BAR_WORDS 3456
#define XB_SPIN_CAP (1u << 22)
__device__ __forceinline__ unsigned xb_ld(unsigned* p) { return __hip_atomic_load(p, __ATOMIC_RELAXED, __HIP_MEMORY_SCOPE_AGENT); }
__device__ __forceinline__ unsigned xb_add(unsigned* p, unsigned v) { return __hip_atomic_fetch_add(p, v, __ATOMIC_RELAXED, __HIP_MEMORY_SCOPE_AGENT); }
__device__ __forceinline__ unsigned xb_xcc_id() { return (unsigned)__builtin_amdgcn_s_getreg((3 << 11) | 20) & 0xFu; }
#define XB_SPIN(cond, bar) do { unsigned _sp = 0; while (cond) { __builtin_amdgcn_s_sleep(1); \
    if ((++_sp & 255u) == 0u) { if (xb_ld(&(bar)[XB_TMO])) break; if (_sp > XB_SPIN_CAP) { atomicAdd(&(bar)[XB_TMO], 1u); break; } } } } while (0)
struct XcdBarrier { unsigned* bar; unsigned x, nloc, nx; };
__device__ __forceinline__ XcdBarrier xcd_barrier_post(unsigned* bar) {
  XcdBarrier b; b.bar = bar; b.x = xb_xcc_id(); b.nloc = 0u; b.nx = 0u;
  if (threadIdx.x == 0) (void)xb_add(&bar[XB_XCNT(b.x)], 1u);
  return b;
}
__device__ __forceinline__ void xcd_barrier_complete(unsigned* bar, unsigned x, unsigned& nloc, unsigned& nx) {
  const unsigned G = gridDim.x;
  unsigned sum, cnt, mine, sp = 0u;
  for (;;) {
    sum = 0u; cnt = 0u; mine = 0u;
#pragma unroll
    for (unsigned j = 0; j < 16; ++j) { const unsigned c = xb_ld(&bar[XB_XCNT(j)]); sum += c; cnt += (c > 0u) ? 1u : 0u; mine = (j == x) ? c : mine; }
    if (sum == G) break;
    __builtin_amdgcn_s_sleep(1);
    if ((++sp & 255u) == 0u) { if (xb_ld(&bar[XB_TMO])) break; if (sp > XB_SPIN_CAP) { atomicAdd(&bar[XB_TMO], 1u); break; } }
  }
  nloc = mine > 0u ? mine : 1u; nx = cnt > 0u ? cnt : 1u;
}
__device__ __forceinline__ void xcd_barrier(XcdBarrier& b) {
  asm volatile("s_waitcnt vmcnt(0)" ::: "memory");
  __syncthreads();
  if (threadIdx.x == 0) {
    unsigned* bar = b.bar;
    __builtin_amdgcn_s_waitcnt(0);
    if (b.nloc == 0u) xcd_barrier_complete(bar, b.x, b.nloc, b.nx);
    const unsigned nloc = b.nloc, nx = b.nx;
    const unsigned old = xb_add(&bar[XB_XSUB(b.x)], 1u);
    const unsigned gen = old / nloc;
    if (old + 1u == (gen + 1u) * nloc) {
      __builtin_amdgcn_fence(__ATOMIC_RELEASE, "agent");
      asm volatile("s_waitcnt vmcnt(0)" ::: "memory");
      const unsigned og = xb_add(&bar[XB_TOP], 1u);
      const unsigned tg = og / nx;
      if (og + 1u == (tg + 1u) * nx) xb_add(&bar[XB_TOPGEN], 1u);
      else XB_SPIN(xb_ld(&bar[XB_TOPGEN]) == tg, bar);
      __builtin_amdgcn_fence(__ATOMIC_ACQUIRE, "agent");
      xb_add(&bar[XB_XGEN(b.x)], 1u);
      asm volatile("s_waitcnt vmcnt(0)" ::: "memory");
    } else {
      XB_SPIN(xb_ld(&bar[XB_XGEN(b.x)]) == gen, bar);
      __builtin_amdgcn_fence(__ATOMIC_ACQUIRE, "agent");
      asm volatile("s_waitcnt vmcnt(0)" ::: "memory");
    }
  }
  __syncthreads();
}

#define LDSP(p) ((__attribute__((address_space(3))) void*)(p))
struct GemmSrc {
  __amdgpu_buffer_rsrc_t ra, rb;
  int va[4], vb[4];
};
__device__ __forceinline__ GemmSrc gemm_src(const u16* A, long lda, const u16* B, long ldb, int tid) {
  GemmSrc g;
  g.ra = __builtin_amdgcn_make_buffer_rsrc((void*)A, 0, 0x7fffffff, 0x00020000);
  g.rb = __builtin_amdgcn_make_buffer_rsrc((void*)B, 0, 0x7fffffff, 0x00020000);
#pragma unroll
  for (int i = 0; i < 4; ++i) {
    int s = i * 256 + tid;
    int row = s >> 3, cs = s & 7;
    int c = cs ^ ((row >> 1) & 7);
    g.va[i] = (int)((row * lda + c * 8) * 2);
    g.vb[i] = (int)((row * ldb + c * 8) * 2);
  }
  return g;
}
__device__ __forceinline__ void gemm_stage(const GemmSrc& g, int k0, unsigned char* buf, int tid) {
#pragma unroll
  for (int i = 0; i < 4; ++i) {
    __builtin_amdgcn_raw_ptr_buffer_load_lds(g.ra, LDSP(buf + (i * 256 + tid) * 16), 16, g.va[i], k0 * 2, 0, 0);
    __builtin_amdgcn_raw_ptr_buffer_load_lds(g.rb, LDSP(buf + 16384 + (i * 256 + tid) * 16), 16, g.vb[i], k0 * 2, 0, 0);
  }
}

template <int KKU = 2>
__device__ __forceinline__ void gemm_acc(f32x4 (&acc)[4][4], const u16* A, long lda, const u16* B, long ldb, int K, unsigned char* smem, bool swap,
                                         bool prefetched = false, const u16* nA = nullptr, long nlda = 0, const u16* nB = nullptr, long nldb = 0) {
  const int tid = ltid(), wid = __builtin_amdgcn_readfirstlane(tid >> 6), lane = tid & 63, wr = wid >> 1, wc = wid & 1, fr = lane & 15, fq = lane >> 4;
  const int nt = K >> 6;
  const GemmSrc g = gemm_src(A, lda, B, ldb, tid);
  if (!prefetched) gemm_stage(g, 0, smem, tid);
  for (int t = 0; t < nt; ++t) {
    asm volatile("s_waitcnt vmcnt(0)" ::: "memory");
    __syncthreads();
    if (t + 1 < nt) gemm_stage(g, (t + 1) * 64, smem + ((t + 1) & 1) * 32768, tid);
    else if (nA) { const GemmSrc gn = gemm_src(nA, nlda, nB, nldb, tid); gemm_stage(gn, 0, smem, tid); }
    const unsigned char* cb = smem + (t & 1) * 32768;
    if (KKU == 2) {
      bf16x8 a0[4], b0[4], a1[4], b1[4];
#pragma unroll
      for (int m = 0; m < 4; ++m) { int row = wr * 64 + m * 16 + fr; a0[m] = *(const bf16x8*)(cb + row * 128 + ((fq ^ ((row >> 1) & 7)) << 4)); }
#pragma unroll
      for (int n = 0; n < 4; ++n) { int row = wc * 64 + n * 16 + fr; b0[n] = *(const bf16x8*)(cb + 16384 + row * 128 + ((fq ^ ((row >> 1) & 7)) << 4)); }
#pragma unroll
      for (int m = 0; m < 4; ++m) { int row = wr * 64 + m * 16 + fr; a1[m] = *(const bf16x8*)(cb + row * 128 + (((4 + fq) ^ ((row >> 1) & 7)) << 4)); }
#pragma unroll
      for (int n = 0; n < 4; ++n) { int row = wc * 64 + n * 16 + fr; b1[n] = *(const bf16x8*)(cb + 16384 + row * 128 + (((4 + fq) ^ ((row >> 1) & 7)) << 4)); }
      __builtin_amdgcn_sched_barrier(0);
      if (swap) {
#pragma unroll
        for (int m = 0; m < 4; ++m)
#pragma unroll
          for (int n = 0; n < 4; ++n) acc[m][n] = __builtin_amdgcn_mfma_f32_16x16x32_bf16(b0[n], a0[m], acc[m][n], 0, 0, 0);
      } else {
#pragma unroll
        for (int m = 0; m < 4; ++m)
#pragma unroll
          for (int n = 0; n < 4; ++n) acc[m][n] = __builtin_amdgcn_mfma_f32_16x16x32_bf16(a0[m], b0[n], acc[m][n], 0, 0, 0);
      }
      __builtin_amdgcn_sched_barrier(0);
      if (swap) {
#pragma unroll
        for (int m = 0; m < 4; ++m)
#pragma unroll
          for (int n = 0; n < 4; ++n) acc[m][n] = __builtin_amdgcn_mfma_f32_16x16x32_bf16(b1[n], a1[m], acc[m][n], 0, 0, 0);
      } else {
#pragma unroll
        for (int m = 0; m < 4; ++m)
#pragma unroll
          for (int n = 0; n < 4; ++n) acc[m][n] = __builtin_amdgcn_mfma_f32_16x16x32_bf16(a1[m], b1[n], acc[m][n], 0, 0, 0);
      }
    } else {
#pragma unroll 1
      for (int kk = 0; kk < 2; ++kk) {
        bf16x8 af[4], bfr[4];
        const int c = kk * 4 + fq;
#pragma unroll
        for (int m = 0; m < 4; ++m) {
          int row = wr * 64 + m * 16 + fr;
          af[m] = *(const bf16x8*)(cb + row * 128 + ((c ^ ((row >> 1) & 7)) << 4));
        }
#pragma unroll
        for (int n = 0; n < 4; ++n) {
          int row = wc * 64 + n * 16 + fr;
          bfr[n] = *(const bf16x8*)(cb + 16384 + row * 128 + ((c ^ ((row >> 1) & 7)) << 4));
        }
        if (swap) {
#pragma unroll
          for (int m = 0; m < 4; ++m)
#pragma unroll
            for (int n = 0; n < 4; ++n) acc[m][n] = __builtin_amdgcn_mfma_f32_16x16x32_bf16(bfr[n], af[m], acc[m][n], 0, 0, 0);
        } else {
#pragma unroll
          for (int m = 0; m < 4; ++m)
#pragma unroll
            for (int n = 0; n < 4; ++n) acc[m][n] = __builtin_amdgcn_mfma_f32_16x16x32_bf16(af[m], bfr[n], acc[m][n], 0, 0, 0);
        }
      }
    }
  }
  if (!nA) __syncthreads();
}

__device__ __forceinline__ void store_pair16_nt(u16* rowp, uint2 a, uint2 b, int fq) {
  auto r = __builtin_amdgcn_permlane16_swap(a.x, b.x, false, false);
  auto s_ = __builtin_amdgcn_permlane16_swap(a.y, b.y, false, false);
  __builtin_nontemporal_store(u32x4{r[0], s_[0], r[1], s_[1]}, (u32x4*)(rowp + ((fq & 1) << 4) + ((fq >> 1) << 3)));
}
__device__ __forceinline__ void store_pair16(u16* rowp, uint2 a, uint2 b, int fq) {
  auto r = __builtin_amdgcn_permlane16_swap(a.x, b.x, false, false);
  auto s_ = __builtin_amdgcn_permlane16_swap(a.y, b.y, false, false);
  *(u32x4*)(rowp + ((fq & 1) << 4) + ((fq >> 1) << 3)) = u32x4{r[0], s_[0], r[1], s_[1]};
}

__device__ __forceinline__ void zero_acc(f32x4 (&acc)[4][4]) {
#pragma unroll
  for (int m = 0; m < 4; ++m)
#pragma unroll
    for (int n = 0; n < 4; ++n) acc[m][n] = f32x4{0.f, 0.f, 0.f, 0.f};
}


__device__ __forceinline__ void tile_map_n8(int t, int& pm, int& pn) {
  const int x = t & 7, q = t >> 3, j = q & 63, c = x + 8 * (q >> 6);
  pm = c * 8 + (j & 7); pn = j >> 3;
}
__device__ __forceinline__ void tile_map_n32(int t, int& pm, int& pn) {
  const int x = t & 7, q = t >> 3, j = q & 63, c = x + 8 * (q >> 6);
  pm = (c >> 2) * 8 + (j & 7); pn = (c & 3) * 8 + (j >> 3);
}

__device__ __forceinline__ void tile_map_n12(int t, int& pm, int& pn) {
  const int x = t & 7, q = t >> 3;
  int j = q & 63, kk = q >> 6, c;
  if (kk < 7) c = x + 8 * kk;
  else { c = 56 + (x >> 1); j += 32 * (x & 1); }
  const int pr = c / 3, pc = c - pr * 3;
  pm = pr * 16 + (j & 15); pn = pc * 4 + (j >> 4);
}

__device__ __forceinline__ int cond_index(int t) { return t < T_P ? 0 : 1 + ((t - T_P) >> 12); }

__device__ __forceinline__ const float* x_in_row(const Params& p, int layer, int t) {
  if (layer == 0) return t < T_P ? pin(p, 0) + (long)t * 1024 : pin(p, 1) + (long)(t - T_P) * 1024;
  return lout(p) + (long)t * 1024;
}

__device__ const int WD_CNT[9] = {384, 768, 48, 32, 128, 64, 256, 1024, 1024};
__device__ const int WD_TAB[9][5] = {{10, 4544, 0, 1024, 1536}, {10, 4544, 1472, 1024, 3072}, {13, 768, 0, 256, 768}, {14, 1024, 0, 128, 1024},
                                     {21, 1024, 0, 512, 1024},  {22, 1024, 0, 256, 1024},     {23, 1024, 0, 1024, 1024}, {25, 4096, 0, 1024, 4096},
                                     {26, 1024, 0, 4096, 1024}};
__device__ const unsigned long WD_DST[9] = {WT_IN1, WT_GATE, WT_QUP, WT_KVUP, WT_OMLA, WT_OGLA, WT_OUT, WT_FF1, WT_FF2};
__device__ __forceinline__ void transpose_tile(const float* src, int ld, int ncol0, int nvalid, u16* dst, int K, int kt, int nt, unsigned char* smem) {
  float* tile = (float*)smem;
  const int tid = ltid();
  const int k0 = kt * 64, n0 = nt * 64;
#pragma unroll
  for (int i = 0; i < 4; ++i) {
    int k = i * 16 + (tid >> 4), n4 = (tid & 15) * 4;
    int nc = ncol0 + n0 + n4;
    float4 v = (nc < nvalid) ? ld_nt4(src + (long)(k0 + k) * ld + nc) : float4{0.f, 0.f, 0.f, 0.f};
    float* tp = tile + k * 65 + n4;
    tp[0] = v.x; tp[1] = v.y; tp[2] = v.z; tp[3] = v.w;
  }
  __syncthreads();
  {
    int n = tid >> 2, kq = (tid & 3) * 16;
    const float* tp = tile + kq * 65 + n;
    u32x4 w0, w1;
#pragma unroll
    for (int j = 0; j < 4; ++j) {
      w0[j] = pk2(tp[(2 * j) * 65], tp[(2 * j + 1) * 65]);
      w1[j] = pk2(tp[(8 + 2 * j) * 65], tp[(8 + 2 * j + 1) * 65]);
    }
    u16* dp = dst + (long)(n0 + n) * K + k0 + kq;
    *(u32x4*)dp = w0;
    *(u32x4*)(dp + 8) = w1;
  }
  __syncthreads();
}

__device__ __forceinline__ void phase_prep(const Params& p, int layer, unsigned char* smem) {
  const int tid = ltid();
  const int total = 384 + 768 + 48 + 32 + 128 + 64 + 256 + 1024 + 1024;
  const int n_fold = 128;
  const int n_mod = (layer == 0) ? 192 : 0;
  const int n_tab = (layer == 0) ? 96 : 0;
  const int all = total + n_fold + n_mod + n_tab;
  for (int it = lbid(); it < all; it += gridDim.x) {
    if (it < total) {
      int r = it, w = 0;
#pragma unroll 1
      while (r >= WD_CNT[w]) { r -= WD_CNT[w]; ++w; }
      const int in_idx = WD_TAB[w][0], ld = WD_TAB[w][1], ncol0 = WD_TAB[w][2], nvalid = WD_TAB[w][1], K = WD_TAB[w][3], N = WD_TAB[w][4];
      const long lofs = (long)K * ld;
      const size_t dst = WD_DST[w];
      int nN = N / 64;
      transpose_tile(pin(p, in_idx) + (long)layer * lofs, ld, ncol0, nvalid, (u16*)(lwt(p, layer) + dst), K, r / nN, r % nN, smem);
    } else if (it < total + n_fold) {
      int j = it - total;
      int gri = j >> 4, dblk = (j >> 2) & 3, cq = j & 3;
      int g = gri >> 1, ri = gri & 1;
      int d = dblk * 256 + tid;
      float* tab = (float*)smem;
      if (tid < 64) tab[tid] = ri ? sin_rev(tid * (1.f / 64.f)) : cos_rev(tid * (1.f / 64.f));
      __syncthreads();
      const float* W = pin(p, 20) + (long)layer * 256 * 1024 + (long)(g * 64) * 1024 + d;
      float wv[64];
#pragma unroll
      for (int m = 0; m < 64; ++m) wv[m] = W[(long)m * 1024];
      u16* dst = (u16*)(lwt(p, layer) + WT_OF) + (long)d * 512 + g * 128 + ri * 64;
      for (int c = cq * 16; c < cq * 16 + 16; c += 2) {
        float a0 = 0.f, a1 = 0.f;
#pragma unroll
        for (int m = 0; m < 64; ++m) { a0 += wv[m] * tab[(m * c) & 63]; a1 += wv[m] * tab[(m * (c + 1)) & 63]; }
        *(unsigned*)(dst + c) = pk2(a0, a1);
      }
      __syncthreads();
    } else if (it < total + n_fold + n_mod) {
      int j = it - total - n_fold;
      int l = j / 96, nb = j % 96;
      float* sc = (float*)smem;
      for (int idx = tid; idx < 9 * 1024; idx += 256) {
        int ci = idx >> 10, k = idx & 1023;
        float v = ci == 0 ? pin(p, 6)[k] : pin(p, 2)[(ci - 1) * 1024 + k];
        sc[idx] = siluf_(v);
      }
      __syncthreads();
      int kg = tid >> 6, n = nb * 64 + (tid & 63);
      float a[9];
#pragma unroll
      for (int ci = 0; ci < 9; ++ci) a[ci] = 0.f;
      const float* W = pin(p, 7) + (long)l * 1024 * 6144 + n;
#pragma unroll 4
      for (int k = kg * 256; k < kg * 256 + 256; ++k) {
        float w = W[(long)k * 6144];
#pragma unroll
        for (int ci = 0; ci < 9; ++ci) a[ci] += sc[ci * 1024 + k] * w;
      }
      __syncthreads();
      float* red = (float*)smem;
#pragma unroll
      for (int ci = 0; ci < 9; ++ci) red[(kg * 9 + ci) * 64 + (tid & 63)] = a[ci];
      __syncthreads();
      for (int idx = tid; idx < 9 * 64; idx += 256) {
        int ci = idx >> 6, nn = idx & 63;
        float s = red[(0 * 9 + ci) * 64 + nn] + red[(1 * 9 + ci) * 64 + nn] + red[(2 * 9 + ci) * 64 + nn] + red[(3 * 9 + ci) * 64 + nn];
        int ncol = nb * 64 + nn;
        ((float*)(lws(p) + WS_MOD))[(l * 9 + ci) * 6144 + ncol] = s + pin(p, 8)[l * 6144 + ncol];
      }
      __syncthreads();
    } else {
      int j = it - total - n_fold - n_mod;
      int idx = j * 256 + tid;
      if (idx < 128 * 64) {
        int r = idx >> 6, n = idx & 63;
        float v = (r < 64) ? cos_rev(((r * n) & 63) * (1.f / 64.f)) : -sin_rev((((r - 64) * n) & 63) * (1.f / 64.f));
        ((u16*)(lws(p) + WS_D1))[idx] = f2bf(v);
      } else {
        int e = idx - 128 * 64;
        int r = e >> 7, kk = e & 127;
        int k2 = r & 63, ro = r >> 6, n2 = kk & 63, ri = kk >> 6;
        float fr_ = ((k2 * n2) & 63) * (1.f / 64.f);
        float v;
        if (ro == 0) v = ri == 0 ? cos_rev(fr_) : sin_rev(fr_);
        else v = ri == 0 ? -sin_rev(fr_) : cos_rev(fr_);
        ((u16*)(lws(p) + WS_D2))[e] = f2bf(v);
      }
    }
  }
}

__device__ __forceinline__ float4 load_x4(const Params& p, bool from_input, int t, int c4) {
  if (from_input) return ((const float4*)x_in_row(p, 0, t))[c4];
  uint2 w = *(const uint2*)((const u16*)lout(p) + (long)t * 1024 + c4 * 4);
  return float4{bflo(w.x), bfhi(w.x), bflo(w.y), bfhi(w.y)};
}
__device__ __forceinline__ void phase_norm(const Params& p, int layer, int which, bool x_from_input, bool store_xb = false) {
  const int lane = ltid() & 63;
  const int wg = lbid() * 4 + __builtin_amdgcn_readfirstlane(ltid() >> 6), nw = gridDim.x * 4;
  const float* g = pin(p, which ? 24 : 9) + layer * 1024;
  u16* H = (u16*)(lws(p) + WS_H);
  constexpr int RB = 4;
  const int rpw = ((T_ALL + nw - 1) / nw + RB - 1) / RB * RB;
  int ci_prev = -1;
  float4 G[2][2], SH[2][2];
  for (int k = 0; k < rpw; k += RB) {
    const int t0 = wg * rpw + k;
    if (t0 >= T_ALL) break;
    int tr[RB];
#pragma unroll
    for (int q = 0; q < RB; ++q) tr[q] = which ? (T_ALL - 1 - (t0 + q)) : (t0 + q);
    const int ci = cond_index(tr[0]);
    if (ci != ci_prev) {
      ci_prev = ci;
      const float* mod = (const float*)(lws(p) + WS_MOD) + (layer * 9 + ci) * 6144 + which * 3072;
#pragma unroll
      for (int i = 0; i < 2; ++i)
#pragma unroll
        for (int h2 = 0; h2 < 2; ++h2) {
          int c4 = (lane + 64 * i) * 2 + h2;
          float4 gg = ((const float4*)g)[c4];
          float4 sc = ((const float4*)(mod + 1024))[c4];
          SH[i][h2] = ((const float4*)mod)[c4];
          G[i][h2] = float4{gg.x * (1.f + sc.x), gg.y * (1.f + sc.y), gg.z * (1.f + sc.z), gg.w * (1.f + sc.w)};
        }
    }
    float4 v[RB][2][2];
    float ss[RB];
#pragma unroll
    for (int q = 0; q < RB; ++q) {
      const int t = tr[q];
#pragma unroll
      for (int i = 0; i < 2; ++i) {
        const int c8 = lane + 64 * i;
        if (x_from_input) {
          const float4* xr = (const float4*)x_in_row(p, 0, t);
          v[q][i][0] = ld_nt4((const float*)(xr + c8 * 2));
          v[q][i][1] = ld_nt4((const float*)(xr + c8 * 2 + 1));
        } else {
          u32x4 w = *(const u32x4*)((const u16*)lout(p) + (long)t * 1024 + c8 * 8);
          v[q][i][0] = float4{bflo(w[0]), bfhi(w[0]), bflo(w[1]), bfhi(w[1])};
          v[q][i][1] = float4{bflo(w[2]), bfhi(w[2]), bflo(w[3]), bfhi(w[3])};
        }
      }
    }
#pragma unroll
    for (int q = 0; q < RB; ++q) {
      float a = 0.f;
#pragma unroll
      for (int i = 0; i < 2; ++i)
#pragma unroll
        for (int h2 = 0; h2 < 2; ++h2) a += v[q][i][h2].x * v[q][i][h2].x + v[q][i][h2].y * v[q][i][h2].y + v[q][i][h2].z * v[q][i][h2].z + v[q][i][h2].w * v[q][i][h2].w;
      ss[q] = a;
    }
#pragma unroll
    for (int o = 32; o > 0; o >>= 1)
#pragma unroll
      for (int q = 0; q < RB; ++q) ss[q] += __shfl_xor(ss[q], o);
#pragma unroll
    for (int q = 0; q < RB; ++q) {
      const float r = rsqrtf(ss[q] * (1.f / 1024.f) + 1e-6f);
#pragma unroll
      for (int i = 0; i < 2; ++i) {
        u32x4 o4;
#pragma unroll
        for (int h2 = 0; h2 < 2; ++h2) {
          float4 x4 = v[q][i][h2], gg = G[i][h2], sh = SH[i][h2];
          o4[2 * h2] = pk2(x4.x * r * gg.x + sh.x, x4.y * r * gg.y + sh.y);
          o4[2 * h2 + 1] = pk2(x4.z * r * gg.z + sh.z, x4.w * r * gg.w + sh.w);
        }
        *(u32x4*)(H + (long)tr[q] * 1024 + (lane + 64 * i) * 8) = o4;
      }
    }
  }
}

__device__ __forceinline__ void phase_in_gemm(const Params& p, int layer, unsigned char* smem) {
  const int tid = ltid(), wid = __builtin_amdgcn_readfirstlane(tid >> 6), lane = tid & 63, wr = wid >> 1, wc = wid & 1, fr = lane & 15, fq = lane >> 4;
  const u16* H = (const u16*)(lws(p) + WS_H);
  const u16* W = (const u16*)(lwt(p, layer) + WT_IN1);
  u16* Zo = (u16*)(lws(p) + WS_Z1);
  const int nN = Z1 / 128, ntiles = (T_ALL / 128) * nN;
  bool pf = false;
  for (int t = lbid(); t < ntiles; t += gridDim.x) {
    int pm, pn, pmn = 0, pnn = 0;
    tile_map_n12(t, pm, pn);
    const int tn = t + gridDim.x;
    const bool hn = tn < ntiles;
    if (hn) tile_map_n12(tn, pmn, pnn);
    f32x4 acc[4][4];
    zero_acc(acc);
    gemm_acc(acc, H + (long)pm * 128 * 1024, 1024, W + (long)pn * 128 * 1024, 1024, 1024, smem, true, pf,
             hn ? H + (long)pmn * 128 * 1024 : nullptr, 1024, W + (long)pnn * 128 * 1024, 1024);
    pf = hn;
#pragma unroll
    for (int m = 0; m < 4; ++m)
#pragma unroll
      for (int n = 0; n < 4; n += 2) {
        int tok = pm * 128 + wr * 64 + m * 16 + fr, col = pn * 128 + wc * 64 + n * 16;
        uint2 a = uint2{pk2(acc[m][n][0], acc[m][n][1]), pk2(acc[m][n][2], acc[m][n][3])};
        uint2 b = uint2{pk2(acc[m][n + 1][0], acc[m][n + 1][1]), pk2(acc[m][n + 1][2], acc[m][n + 1][3])};
        store_pair16(Zo + (long)tok * Z1 + col, a, b, fq);
      }
  }
}

__device__ __forceinline__ float logsig(float x) { return fminf(x, 0.f) - __logf(1.f + __expf(-fabsf(x))); }

__device__ __forceinline__ void gla_prep(const Params& p, int layer, int t0, int hh, float* laf, float* lab, float* wa, float* ba) {
  const int tid = ltid();
  for (int idx = tid; idx < 1024; idx += 256) {
    int dir = idx >> 9, r = (idx >> 5) & 15, d = idx & 31;
    wa[idx] = pin(p, dir ? 17 : 15)[layer * 2048 + r * 128 + hh * 32 + d];
  }
  if (tid < 64) {
    int dir = tid >> 5, d = tid & 31;
    ba[tid] = pin(p, dir ? 18 : 16)[layer * 128 + hh * 32 + d];
  }
  __syncthreads();
  {
    int i = tid >> 2, d0 = (tid & 3) * 8;
    const u16* zr = (const u16*)(lws(p) + WS_Z1) + (long)(t0 + i) * Z1;
    uint4 a0 = *(const uint4*)(zr + 1440), a1 = *(const uint4*)(zr + 1448);
    uint4 b0 = *(const uint4*)(zr + 1456), b1 = *(const uint4*)(zr + 1464);
    unsigned aw[8] = {a0.x, a0.y, a0.z, a0.w, a1.x, a1.y, a1.z, a1.w};
    unsigned bw[8] = {b0.x, b0.y, b0.z, b0.w, b1.x, b1.y, b1.z, b1.w};
#pragma unroll 1
    for (int e = 0; e < 8; ++e) {
      int d = d0 + e;
      float xf = ba[d], xb = ba[32 + d];
#pragma unroll
      for (int r = 0; r < 8; ++r) {
        xf += bflo(aw[r]) * wa[(2 * r) * 32 + d] + bfhi(aw[r]) * wa[(2 * r + 1) * 32 + d];
        xb += bflo(bw[r]) * wa[512 + (2 * r) * 32 + d] + bfhi(bw[r]) * wa[512 + (2 * r + 1) * 32 + d];
      }
      laf[i * 32 + d] = logsig(xf) * (1.f / 16.f);
      lab[i * 32 + d] = logsig(xb) * (1.f / 16.f);
    }
  }
  __syncthreads();
  {
    const int seg = tid >> 6, dir = (tid >> 5) & 1, d = tid & 31;
    float* arr = dir ? lab : laf;
    float* segtot = wa;
    float run = 0.f;
    if (dir == 0) {
#pragma unroll 4
      for (int i = seg * 16; i < seg * 16 + 16; ++i) { run += arr[i * 32 + d]; arr[i * 32 + d] = run; }
    } else {
#pragma unroll 4
      for (int i = seg * 16 + 15; i >= seg * 16; --i) { run += arr[i * 32 + d]; arr[i * 32 + d] = run; }
    }
    __syncthreads();
    segtot[(dir * 4 + seg) * 32 + d] = run;
    __syncthreads();
    float off = 0.f;
    if (dir == 0) { for (int s2 = 0; s2 < seg; ++s2) off += segtot[(0 * 4 + s2) * 32 + d]; }
    else { for (int s2 = seg + 1; s2 < 4; ++s2) off += segtot[(1 * 4 + s2) * 32 + d]; }
#pragma unroll 4
    for (int i = seg * 16; i < seg * 16 + 16; ++i) arr[i * 32 + d] += off;
  }
  __syncthreads();
}

__device__ __forceinline__ void gla_local(const Params& p, int layer, int item, unsigned char* smem) {
  const int tid = ltid(), wid = __builtin_amdgcn_readfirstlane(tid >> 6), lane = tid & 63, fr = lane & 15, fq = lane >> 4;
  const int ci = item >> 2, hh = item & 3, t0 = ci * 64;
  float* laf = (float*)smem;
  float* lab = laf + 2048;
  float* wa = lab + 2048;
  float* ba = wa + 1024;
  u16* khf = (u16*)(smem + 20736);
  u16* khb = khf + 32 * 72;
  u16* vt = khb + 32 * 72;
  gla_prep(p, layer, t0, hh, laf, lab, wa, ba);
  {
    int i = tid >> 2, d0 = (tid & 3) * 8;
    const u16* zr = (const u16*)(lws(p) + WS_Z1) + (long)(t0 + i) * Z1;
    uint4 kq = *(const uint4*)(zr + 800 + hh * 32 + d0);
    unsigned kw[4] = {kq.x, kq.y, kq.z, kq.w};
#pragma unroll
    for (int e = 0; e < 8; ++e) {
      int d = d0 + e;
      float kv = (e & 1) ? bfhi(kw[e >> 1]) : bflo(kw[e >> 1]);
      khf[d * 72 + i] = f2bf(kv * __expf(laf[63 * 32 + d] - laf[i * 32 + d]));
      khb[d * 72 + i] = f2bf(kv * __expf(lab[d] - lab[i * 32 + d]));
    }
    int e0 = (tid & 3) * 16;
    uint4 v0 = *(const uint4*)(zr + 928 + hh * 64 + e0), v1 = *(const uint4*)(zr + 928 + hh * 64 + e0 + 8);
    unsigned vw[8] = {v0.x, v0.y, v0.z, v0.w, v1.x, v1.y, v1.z, v1.w};
#pragma unroll
    for (int e = 0; e < 16; ++e) vt[(e0 + e) * 72 + i] = (u16)((e & 1) ? (vw[e >> 1] >> 16) : (vw[e >> 1] & 0xffffu));
  }
  float* dec = (float*)(lws(p) + WS_GDEC) + (long)item * 64;
  if (tid < 32) dec[tid] = __expf(laf[63 * 32 + tid]);
  else if (tid < 64) dec[tid] = __expf(lab[tid - 32]);
  __syncthreads();
  u16* dS = (u16*)(lws(p) + WS_GDS) + (long)item * 2 * 2048;
#pragma unroll
  for (int dir = 0; dir < 2; ++dir) {
    const u16* kh = dir ? khb : khf;
#pragma unroll
    for (int dt = 0; dt < 2; ++dt) {
      f32x4 acc = {0.f, 0.f, 0.f, 0.f};
#pragma unroll
      for (int kk = 0; kk < 2; ++kk) {
        bf16x8 a = *(const bf16x8*)(vt + (wid * 16 + fr) * 72 + kk * 32 + fq * 8);
        bf16x8 b = *(const bf16x8*)(kh + (dt * 16 + fr) * 72 + kk * 32 + fq * 8);
        acc = __builtin_amdgcn_mfma_f32_16x16x32_bf16(a, b, acc, 0, 0, 0);
      }
#pragma unroll
      for (int j = 0; j < 4; ++j) dS[dir * 2048 + (wid * 16 + fq * 4 + j) * 32 + dt * 16 + fr] = f2bf(acc[j]);
    }
  }
  __syncthreads();
}

__device__ __forceinline__ void gla_scan_block(const Params& p, int layer, int blk) {
  const int tid = ltid();
  int seq = blk >> 3, elem = (blk & 7) * 256 + tid;
  int e = elem >> 5, d = elem & 31;
  int b, hh, dir, c0, n;
  bool prompt = seq < 256;
  if (prompt) { b = seq >> 3; hh = (seq >> 1) & 3; dir = seq & 1; c0 = b * 4; n = 4; }
  else { int s = seq - 256; b = s >> 3; hh = (s >> 1) & 3; dir = s & 1; c0 = 128 + b * 64; n = 64; }
  const u16* dS = (const u16*)(lws(p) + WS_GDS);
  u16* SS = (u16*)(lws(p) + WS_GSS);
  const float* dec = (const float*)(lws(p) + WS_GDEC);
  float S = 0.f;
  if (!prompt) S = pin(p, 5)[((((long)(b * 2 + layer) * 2 + dir) * 4 + hh) * 32 + d) * 64 + e];
  if (prompt) {
    float ds[4], dc[4];
    long sl[4];
#pragma unroll
    for (int c = 0; c < 4; ++c) {
      int ci = dir ? (c0 + 3 - c) : (c0 + c);
      sl[c] = ((long)(ci * 4 + hh) * 2 + dir);
      ds[c] = bf2f(dS[sl[c] * 2048 + elem]);
      dc[c] = dec[sl[c] * 32 + d];
    }
#pragma unroll
    for (int c = 0; c < 4; ++c) { SS[sl[c] * 2048 + elem] = f2bf(S); S = dc[c] * S + ds[c]; }
  } else {
#pragma unroll 1
    for (int cb = 0; cb < 64; cb += 16) {
      float ds[16], dc[16];
#pragma unroll
      for (int c = 0; c < 16; ++c) {
        int ci = dir ? (c0 + 63 - (cb + c)) : (c0 + cb + c);
        long slot = ((long)(ci * 4 + hh) * 2 + dir);
        ds[c] = bf2f(dS[slot * 2048 + elem]);
        dc[c] = dec[slot * 32 + d];
      }
#pragma unroll
      for (int c = 0; c < 16; ++c) {
        int ci = dir ? (c0 + 63 - (cb + c)) : (c0 + cb + c);
        long slot = ((long)(ci * 4 + hh) * 2 + dir);
        SS[slot * 2048 + elem] = f2bf(S);
        S = dc[c] * S + ds[c];
      }
    }
  }
  if (prompt) lout(p)[OUT_ST + ((((long)(b * 2 + layer) * 2 + dir) * 4 + hh) * 32 + d) * 64 + e] = S;
}

__device__ __forceinline__ void gla_output(const Params& p, int layer, int item, unsigned char* smem) {
  const int tid = ltid(), wid = __builtin_amdgcn_readfirstlane(tid >> 6), lane = tid & 63, fr = lane & 15, fq = lane >> 4;
  const int ci = item >> 2, hh = item & 3, t0 = ci * 64;
  float* laf = (float*)smem;
  float* lab = laf + 2048;
  u16* P = (u16*)smem;
  float* wa = (float*)(smem + 18432);
  float* ba = wa + 1024;
  u16* qf = (u16*)(smem + 18432 + 4352);
  u16* kf = qf + 64 * 40;
  u16* qb = kf + 64 * 40;
  u16* kb = qb + 64 * 40;
  u16* vt = kb + 64 * 40;
  gla_prep(p, layer, t0, hh, laf, lab, wa, ba);
  {
    int i = tid >> 2, d0 = (tid & 3) * 8;
    const u16* zr = (const u16*)(lws(p) + WS_Z1) + (long)(t0 + i) * Z1;
    uint4 qq = *(const uint4*)(zr + 672 + hh * 32 + d0);
    uint4 kq = *(const uint4*)(zr + 800 + hh * 32 + d0);
    unsigned qw[4] = {qq.x, qq.y, qq.z, qq.w}, kw[4] = {kq.x, kq.y, kq.z, kq.w};
    const float sc = 0.17677669529663687f;
    unsigned oqf[4], okf[4], oqb[4], okb[4];
#pragma unroll
    for (int e2 = 0; e2 < 4; ++e2) {
      int d = d0 + e2 * 2;
      float q0 = bflo(qw[e2]) * sc, q1 = bfhi(qw[e2]) * sc, k0 = bflo(kw[e2]), k1 = bfhi(kw[e2]);
      float f0 = laf[i * 32 + d], f1 = laf[i * 32 + d + 1], b0 = lab[i * 32 + d], b1 = lab[i * 32 + d + 1];
      oqf[e2] = pk2(q0 * __expf(f0), q1 * __expf(f1));
      okf[e2] = pk2(k0 * __expf(-f0), k1 * __expf(-f1));
      oqb[e2] = pk2(q0 * __expf(b0), q1 * __expf(b1));
      okb[e2] = pk2(k0 * __expf(-b0), k1 * __expf(-b1));
    }
    *(uint4*)(qf + i * 40 + d0) = uint4{oqf[0], oqf[1], oqf[2], oqf[3]};
    *(uint4*)(kf + i * 40 + d0) = uint4{okf[0], okf[1], okf[2], okf[3]};
    *(uint4*)(qb + i * 40 + d0) = uint4{oqb[0], oqb[1], oqb[2], oqb[3]};
    *(uint4*)(kb + i * 40 + d0) = uint4{okb[0], okb[1], okb[2], okb[3]};
    int e0 = (tid & 3) * 16;
    uint4 v0 = *(const uint4*)(zr + 928 + hh * 64 + e0), v1 = *(const uint4*)(zr + 928 + hh * 64 + e0 + 8);
    unsigned vw[8] = {v0.x, v0.y, v0.z, v0.w, v1.x, v1.y, v1.z, v1.w};
#pragma unroll
    for (int e = 0; e < 16; ++e) vt[(e0 + e) * 72 + i] = (u16)((e & 1) ? (vw[e >> 1] >> 16) : (vw[e >> 1] & 0xffffu));
  }
  __syncthreads();
  f32x4 o[4];
#pragma unroll
  for (int et = 0; et < 4; ++et) o[et] = f32x4{0.f, 0.f, 0.f, 0.f};
  const u16* SS = (const u16*)(lws(p) + WS_GSS) + (long)item * 2 * 2048;
#pragma unroll
  for (int dir = 0; dir < 2; ++dir) {
    const u16* qd = dir ? qb : qf;
    const u16* kd = dir ? kb : kf;
    u16* Pd = P + dir * 64 * 72;
    bf16x8 qfrag = *(const bf16x8*)(qd + (wid * 16 + fr) * 40 + fq * 8);
#pragma unroll
    for (int jt = 0; jt < 4; ++jt) {
      bf16x8 kfrag = *(const bf16x8*)(kd + (jt * 16 + fr) * 40 + fq * 8);
      f32x4 s = {0.f, 0.f, 0.f, 0.f};
      s = __builtin_amdgcn_mfma_f32_16x16x32_bf16(kfrag, qfrag, s, 0, 0, 0);
      int i = wid * 16 + fr;
      float pv[4];
#pragma unroll
      for (int r = 0; r < 4; ++r) {
        int j = jt * 16 + fq * 4 + r;
        bool keep = dir ? (j >= i) : (j <= i);
        pv[r] = keep ? s[r] : 0.f;
      }
      uint2 o2;
      o2.x = pk2(pv[0], pv[1]);
      o2.y = pk2(pv[2], pv[3]);
      *(uint2*)(Pd + i * 72 + jt * 16 + fq * 4) = o2;
    }
#pragma unroll
    for (int kk = 0; kk < 2; ++kk) {
      bf16x8 pfrag = *(const bf16x8*)(Pd + (wid * 16 + fr) * 72 + kk * 32 + fq * 8);
#pragma unroll
      for (int et = 0; et < 4; ++et) {
        bf16x8 vfrag = *(const bf16x8*)(vt + (et * 16 + fr) * 72 + kk * 32 + fq * 8);
        o[et] = __builtin_amdgcn_mfma_f32_16x16x32_bf16(vfrag, pfrag, o[et], 0, 0, 0);
      }
    }
#pragma unroll
    for (int et = 0; et < 4; ++et) {
      bf16x8 sfrag = *(const bf16x8*)(SS + dir * 2048 + (et * 16 + fr) * 32 + fq * 8);
      o[et] = __builtin_amdgcn_mfma_f32_16x16x32_bf16(sfrag, qfrag, o[et], 0, 0, 0);
    }
  }
  float ss = 0.f;
#pragma unroll
  for (int et = 0; et < 4; ++et)
#pragma unroll
    for (int r = 0; r < 4; ++r) ss += o[et][r] * o[et][r];
  ss += __shfl_xor(ss, 16);
  ss += __shfl_xor(ss, 32);
  float rn = rsqrtf(ss * (1.f / 64.f) + 1e-6f);
  {
    int i = wid * 16 + fr;
    const u16* zr = (const u16*)(lws(p) + WS_Z1) + (long)(t0 + i) * Z1 + 1184 + hh * 64;
    u16* og = (u16*)(lws(p) + WS_OG) + (long)(t0 + i) * 256 + hh * 64;
    const float* gn = pin(p, 19) + layer * 256 + hh * 64;
#pragma unroll
    for (int et = 0; et < 4; ++et) {
      int e = et * 16 + fq * 4;
      uint2 gr = *(const uint2*)(zr + e);
      float4 g4 = *(const float4*)(gn + e);
      float r0 = o[et][0] * rn * g4.x * siluf_(bflo(gr.x));
      float r1 = o[et][1] * rn * g4.y * siluf_(bfhi(gr.x));
      float r2 = o[et][2] * rn * g4.z * siluf_(bflo(gr.y));
      float r3 = o[et][3] * rn * g4.w * siluf_(bfhi(gr.y));
      uint2 o2;
      o2.x = pk2(r0, r1);
      o2.y = pk2(r2, r3);
      *(uint2*)(og + e) = o2;
    }
  }
  __syncthreads();
}

template <int NT>
__device__ __forceinline__ void latent_prep_tokens(const Params& p, int layer, int t0, int lane) {
  u16* z = (u16*)(lws(p) + WS_Z1);
  const int e = lane & 31;
  uint2 wq[NT];
  unsigned wk[NT];
  float vr[NT];
#pragma unroll
  for (int k = 0; k < NT; ++k) {
    const u16* zr = z + (long)(t0 + k) * Z1;
    wq[k] = *(const uint2*)(zr + 256 + lane * 4);
    wk[k] = *(const unsigned*)(zr + 512 + lane * 2);
    vr[k] = bf2f(zr[640 + e]);
  }
  const float4 gq = *(const float4*)(pin(p, 11) + layer * 256 + lane * 4);
  const float2 gk = *(const float2*)(pin(p, 12) + layer * 128 + lane * 2);
  float sq[NT], sk[NT];
#pragma unroll
  for (int k = 0; k < NT; ++k) {
    float v0 = bflo(wq[k].x), v1 = bfhi(wq[k].x), v2 = bflo(wq[k].y), v3 = bfhi(wq[k].y);
    sq[k] = v0 * v0 + v1 * v1 + v2 * v2 + v3 * v3;
    float c0 = bflo(wk[k]), c1 = bfhi(wk[k]);
    sk[k] = c0 * c0 + c1 * c1;
  }
#pragma unroll
  for (int o = 32; o > 0; o >>= 1)
#pragma unroll
    for (int k = 0; k < NT; ++k) { sq[k] += __shfl_xor(sq[k], o); sk[k] += __shfl_xor(sk[k], o); }
#pragma unroll
  for (int k = 0; k < NT; ++k) {
    const int t = t0 + k;
    u16* zr = z + (long)t * Z1;
    {
      float r = rsqrtf(sq[k] * (1.f / 256.f) + 1e-6f);
      uint2 o2;
      o2.x = pk2(bflo(wq[k].x) * r * gq.x, bfhi(wq[k].x) * r * gq.y);
      o2.y = pk2(bflo(wq[k].y) * r * gq.z, bfhi(wq[k].y) * r * gq.w);
      *(uint2*)(zr + 256 + lane * 4) = o2;
    }
    const bool prompt = t < T_P;
    int b, pos, kt;
    if (prompt) { b = t >> 8; pos = t & 255; kt = t; }
    else { int s_ = t - T_P; b = s_ >> 12; pos = s_ & 4095; kt = T_P + b * 4608 + 512 + pos; }
    {
      float r = rsqrtf(sk[k] * (1.f / 128.f) + 1e-6f);
      float c0 = bflo(wk[k]) * r * gk.x, c1 = bfhi(wk[k]) * r * gk.y;
      *(unsigned*)((u16*)(lws(p) + WS_CKV) + (long)kt * 128 + lane * 2) = pk2(c0, c1);
      if (prompt) *(float2*)(lout(p) + OUT_CKV + ((long)(b * 2 + layer) * 256 + pos) * 128 + lane * 2) = float2{c0, c1};
    }
    {
      float v = vr[k];
      float other = __shfl_xor(v, 8);
      float res = v;
      if (!prompt) {
        int part = e >> 4, idx = e & 15, fi = idx & 7;
        int ps = part ? (pos & 63) : (pos >> 6);
        float inv = exp2f(-(float)fi * 1.6609640474436813f);
        float rev = (float)ps * inv * 0.15915494309189535f;
        rev -= floorf(rev);
        float cs = cos_rev(rev), sn = sin_rev(rev);
        res = ((e & 15) < 8) ? (v * cs - other * sn) : (other * sn + v * cs);
      }
      if (lane < 32) {
        ((u16*)(lws(p) + WS_KR))[(long)kt * 32 + e] = f2bf(res);
        if (prompt) lout(p)[OUT_KR + ((long)(b * 2 + layer) * 256 + pos) * 32 + e] = v;
      }
    }
  }
}

__device__ __forceinline__ void cache_convert_row(const Params& p, int layer, int row, int lane) {
  int b = row >> 9, j = row & 511;
  long kt = T_P + (long)b * 4608 + j;
  const float* src = pin(p, 3) + ((long)(b * 2 + layer) * 512 + j) * 128;
  float2 v = *(const float2*)(src + lane * 2);
  *(unsigned*)((u16*)(lws(p) + WS_CKV) + kt * 128 + lane * 2) = pk2(v.x, v.y);
  if (lane < 32) {
    const float* s2 = pin(p, 4) + ((long)(b * 2 + layer) * 512 + j) * 32;
    ((u16*)(lws(p) + WS_KR))[kt * 32 + lane] = f2bf(s2[lane]);
  }
}

template <int K>
__device__ __forceinline__ void fourier_mma(f32x4 (&acc)[8][2], const u16* Dm, const u16* XT, int wid, int fr, int fq) {
  constexpr int KP = K + 8;
#pragma unroll
  for (int rt = 0; rt < 8; ++rt)
#pragma unroll
    for (int ct = 0; ct < 2; ++ct) acc[rt][ct] = f32x4{0.f, 0.f, 0.f, 0.f};
#pragma unroll 1
  for (int kk = 0; kk < K / 32; ++kk) {
    bf16x8 xf[2];
#pragma unroll
    for (int ct = 0; ct < 2; ++ct) xf[ct] = *(const bf16x8*)(XT + ((wid * 2 + ct) * 16 + fr) * KP + kk * 32 + fq * 8);
#pragma unroll
    for (int rt = 0; rt < 8; ++rt) {
      bf16x8 df = *(const bf16x8*)(Dm + (rt * 16 + fr) * K + kk * 32 + fq * 8);
#pragma unroll
      for (int ct = 0; ct < 2; ++ct) acc[rt][ct] = __builtin_amdgcn_mfma_f32_16x16x32_bf16(xf[ct], df, acc[rt][ct], 0, 0, 0);
    }
  }
}

__device__ __forceinline__ void fourier_p1(const Params& p, int item, unsigned char* smem) {
  const int tid = ltid(), wid = __builtin_amdgcn_readfirstlane(tid >> 6), lane = tid & 63, fr = lane & 15, fq = lane >> 4;
  const int chalf = item & 1, n2 = (item >> 1) & 63, b = item >> 7;
  u16* XT = (u16*)smem;
  const u16* z = (const u16*)(lws(p) + WS_Z1);
  {
    int n1 = tid & 63;
    long tok = T_P + (long)b * 4096 + 64 * n1 + n2;
#pragma unroll
    for (int it = 0; it < 4; ++it) {
      int chunk = it * 4 + (tid >> 6);
      uint4 v = *(const uint4*)(z + tok * Z1 + chalf * 128 + chunk * 8);
      unsigned w[4] = {v.x, v.y, v.z, v.w};
#pragma unroll
      for (int e = 0; e < 8; ++e) XT[(chunk * 8 + e) * 72 + n1] = (u16)((e & 1) ? (w[e >> 1] >> 16) : (w[e >> 1] & 0xffffu));
    }
  }
  __syncthreads();
  f32x4 acc[8][2];
  fourier_mma<64>(acc, (const u16*)(lws(p) + WS_D1), XT, wid, fr, fq);
  u16* VP = (u16*)(lws(p) + WS_VP);
#pragma unroll
  for (int rt = 0; rt < 4; ++rt) {
    int k1 = rt * 16 + fr;
    float frac = (float)((k1 * n2) & 4095) * (1.f / 4096.f);
    float cs = cos_rev(frac), sn = sin_rev(frac);
#pragma unroll
    for (int ct = 0; ct < 2; ++ct) {
      int c = chalf * 128 + (wid * 2 + ct) * 16 + fq * 4;
      float vr[4], vi[4];
#pragma unroll
      for (int j = 0; j < 4; ++j) {
        float a = acc[rt][ct][j], bb = acc[rt + 4][ct][j];
        vr[j] = cs * a + sn * bb;
        vi[j] = cs * bb - sn * a;
      }
      long base = (((long)(b * 64 + n2) * 64 + k1) * 2) * 256;
      *(uint2*)(VP + base + c) = uint2{pk2(vr[0], vr[1]), pk2(vr[2], vr[3])};
      *(uint2*)(VP + base + 256 + c) = uint2{pk2(vi[0], vi[1]), pk2(vi[2], vi[3])};
    }
  }
  __syncthreads();
}

__device__ __forceinline__ void fourier_p2(const Params& p, int item, unsigned char* smem) {
  const int tid = ltid(), wid = __builtin_amdgcn_readfirstlane(tid >> 6), lane = tid & 63, fr = lane & 15, fq = lane >> 4;
  u16* XT = (u16*)smem;
  const bool sample = item < 1024;
  int chalf, k1, b, R;
  long tokbase;
  float nrm;
  if (sample) {
    chalf = item & 1; k1 = (item >> 1) & 63; b = item >> 7; R = 64; tokbase = T_P + (long)b * 4096; nrm = 1.f / 512.f;
    const u16* VP = (const u16*)(lws(p) + WS_VP);
    int kk = tid & 127;
    int ri = kk >> 6, n2 = kk & 63;
    const u16* src = VP + (((long)(b * 64 + n2) * 64 + k1) * 2 + ri) * 256 + chalf * 128;
#pragma unroll
    for (int it = 0; it < 8; ++it) {
      int chunk = it * 2 + (tid >> 7);
      uint4 v = *(const uint4*)(src + chunk * 8);
      unsigned w[4] = {v.x, v.y, v.z, v.w};
#pragma unroll
      for (int e = 0; e < 8; ++e) XT[(chunk * 8 + e) * 136 + kk] = (u16)((e & 1) ? (w[e >> 1] >> 16) : (w[e >> 1] & 0xffffu));
    }
  } else {
    int j = item - 1024;
    chalf = j & 1; k1 = (j >> 1) & 3; b = j >> 3; R = 4; tokbase = (long)b * 256; nrm = 1.f / 128.f;
    const u16* z = (const u16*)(lws(p) + WS_Z1);
    int n2 = tid & 63;
    float frac = (float)((k1 * n2) & 255) * (1.f / 256.f);
    float cs = cos_rev(frac), sn = sin_rev(frac);
#pragma unroll
    for (int it = 0; it < 4; ++it) {
      int chunk = it * 4 + (tid >> 6);
      float vr[8], vi[8];
#pragma unroll
      for (int e = 0; e < 8; ++e) { vr[e] = 0.f; vi[e] = 0.f; }
#pragma unroll
      for (int n1 = 0; n1 < 4; ++n1) {
        uint4 v = *(const uint4*)(z + (tokbase + 64 * n1 + n2) * Z1 + chalf * 128 + chunk * 8);
        unsigned w[4] = {v.x, v.y, v.z, v.w};
        int ee = (k1 * n1) & 3;
        float wre = (ee == 0) ? 1.f : (ee == 2 ? -1.f : 0.f);
        float wim = (ee == 1) ? -1.f : (ee == 3 ? 1.f : 0.f);
#pragma unroll
        for (int e = 0; e < 8; ++e) {
          float x = (e & 1) ? bfhi(w[e >> 1]) : bflo(w[e >> 1]);
          vr[e] += wre * x;
          vi[e] += wim * x;
        }
      }
#pragma unroll
      for (int e = 0; e < 8; ++e) {
        XT[(chunk * 8 + e) * 136 + n2] = f2bf(cs * vr[e] + sn * vi[e]);
        XT[(chunk * 8 + e) * 136 + 64 + n2] = f2bf(cs * vi[e] - sn * vr[e]);
      }
    }
  }
  __syncthreads();
  f32x4 acc[8][2];
  fourier_mma<128>(acc, (const u16*)(lws(p) + WS_D2), XT, wid, fr, fq);
  u16* F = (u16*)(lws(p) + WS_F);
#pragma unroll
  for (int rt = 0; rt < 8; ++rt) {
    int r = rt * 16 + fr, ro = r >> 6, k2 = r & 63;
    long tok = tokbase + k1 + R * k2;
#pragma unroll
    for (int ct = 0; ct < 2; ++ct) {
      int c = chalf * 128 + (wid * 2 + ct) * 16 + fq * 4;
      int fcol = (c >> 6) * 128 + ro * 64 + (c & 63);
      *(uint2*)(F + tok * 512 + fcol) = uint2{pk2(acc[rt][ct][0] * nrm, acc[rt][ct][1] * nrm), pk2(acc[rt][ct][2] * nrm, acc[rt][ct][3] * nrm)};
    }
  }
  __syncthreads();
}

__device__ __forceinline__ void qup_tile(const Params& p, int layer, int t, unsigned char* smem) {
  const int tid = ltid(), wid = __builtin_amdgcn_readfirstlane(tid >> 6), lane = tid & 63, wr = wid >> 1, wc = wid & 1, fr = lane & 15, fq = lane >> 4;
  const int pm = ((t >> 3) / 6) * 8 + (t & 7), pn = (t >> 3) % 6;
  f32x4 acc[4][4];
  zero_acc(acc);
  gemm_acc(acc, (const u16*)(lws(p) + WS_Z1) + (long)pm * 128 * Z1 + 256, Z1, (const u16*)(lwt(p, layer) + WT_QUP) + (long)pn * 128 * 256, 256, 256, smem, true);
  u16* Q = (u16*)lout(p) + Q_OFS;
  const float qs = 0.10206207261596577f * 1.4426950408889634f;
#pragma unroll
  for (int m = 0; m < 4; ++m) {
    int tok = pm * 128 + wr * 64 + m * 16 + fr;
    bool smp = tok >= T_P;
    int pos = (tok - T_P) & 4095;
    uint2 o2[4];
#pragma unroll
    for (int n = 0; n < 4; ++n) {
      int col0 = pn * 128 + wc * 64 + n * 16;
      int dd0 = col0 % 96;
      float v[4];
#pragma unroll
      for (int j = 0; j < 4; ++j) v[j] = acc[m][n][j];
      if (dd0 >= 64) {
        int part = (dd0 - 64) >> 4;
        int ps = part ? (pos & 63) : (pos >> 6);
#pragma unroll
        for (int j = 0; j < 4; ++j) {
          float other = __shfl_xor(v[j], 32);
          int fi = (fq & 1) * 4 + j;
          float inv = exp2f(-(float)fi * 1.6609640474436813f);
          float rev = (float)ps * inv * 0.15915494309189535f;
          rev -= floorf(rev);
          float cs = cos_rev(rev), sn = sin_rev(rev);
          float res = (fq < 2) ? (v[j] * cs - other * sn) : (other * sn + v[j] * cs);
          if (smp) v[j] = res;
        }
      }
      o2[n] = uint2{pk2(v[0] * qs, v[1] * qs), pk2(v[2] * qs, v[3] * qs)};
    }
#pragma unroll
    for (int n = 0; n < 4; n += 2) store_pair16(Q + (long)tok * 768 + pn * 128 + wc * 64 + n * 16, o2[n], o2[n + 1], fq);
  }
}

__device__ __forceinline__ long vt_base(int kt, int& Lk, int& key) {
  if (kt < T_P) { int b = kt >> 8; Lk = 256; key = kt & 255; return (long)b * 512 * 256; }
  int s = kt - T_P; int b = s / 4608; Lk = 4608; key = s - b * 4608; return (long)T_P * 512 + (long)b * 512 * 4608;
}

__device__ __forceinline__ void kvup_tile(const Params& p, int layer, int t, unsigned char* smem) {
  const int tid = ltid(), wid = __builtin_amdgcn_readfirstlane(tid >> 6), lane = tid & 63, wr = wid >> 1, wc = wid & 1, fr = lane & 15, fq = lane >> 4;
  const int pm = ((t >> 6) << 3) + (t & 7), pn = (t >> 3) & 7;
  f32x4 acc[4][4];
  zero_acc(acc);
  gemm_acc(acc, (const u16*)(lws(p) + WS_CKV) + (long)pm * 128 * 128, 128, (const u16*)(lwt(p, layer) + WT_KVUP) + (long)pn * 128 * 128, 128, 128, smem, wc == 0);
  if (wc == 0) {
    u16* KN = (u16*)(lws(p) + WS_KNOPE);
#pragma unroll
    for (int m = 0; m < 4; ++m)
#pragma unroll
      for (int n = 0; n < 4; n += 2) {
        int kt = pm * 128 + wr * 64 + m * 16 + fr;
        store_pair16(KN + (long)kt * 512 + pn * 64 + n * 16, uint2{pk2(acc[m][n][0], acc[m][n][1]), pk2(acc[m][n][2], acc[m][n][3])},
                     uint2{pk2(acc[m][n + 1][0], acc[m][n + 1][1]), pk2(acc[m][n + 1][2], acc[m][n + 1][3])}, fq);
      }
  } else {
    u16* VT = (u16*)(lws(p) + WS_VT);
#pragma unroll
    for (int m = 0; m < 4; m += 2) {
      int kt = pm * 128 + wr * 64 + m * 16;
      int Lk, key;
      long base = vt_base(kt, Lk, key);
#pragma unroll
      for (int n = 0; n < 4; ++n) {
        int dv = n * 16 + fr;
        store_pair16(VT + base + (long)(pn * 64 + dv) * Lk + key, uint2{pk2(acc[m][n][0], acc[m][n][1]), pk2(acc[m][n][2], acc[m][n][3])},
                     uint2{pk2(acc[m + 1][n][0], acc[m + 1][n][1]), pk2(acc[m + 1][n][2], acc[m + 1][n][3])}, fq);
      }
    }
  }
}

constexpr int ATT_KB = 64 * 208;
constexpr int ATT_STAGE = ATT_KB + 64 * 144;
__device__ __forceinline__ void attn_stage(const u16* KNh, const u16* KR, const u16* VTb, long key0, int koff, int Lk, unsigned char* buf, int tid) {
#pragma unroll
  for (int i = 0; i < 4; ++i) {
    int s = i * 256 + tid;
    if (s < 832) {
      int row = s / 13, cs = s - row * 13;
      const u16* src = (cs < 8) ? (KNh + (key0 + row) * 512 + cs * 8) : ((cs < 12) ? (KR + (key0 + row) * 32 + (cs - 8) * 8) : (KNh + (key0 + row) * 512));
      glds16(src, buf + s * 16);
    }
  }
#pragma unroll
  for (int i = 0; i < 3; ++i) {
    int s = i * 256 + tid;
    if (s < 576) {
      int row = s / 9, cs = s - row * 9;
      const u16* src = VTb + (long)row * Lk + koff + ((cs < 8) ? cs * 8 : 0);
      glds16(src, buf + ATT_KB + s * 16);
    }
  }
}

__device__ __forceinline__ void attn_item(const Params& p, int idx, unsigned char* smem) {
  const int tid = ltid(), wid = __builtin_amdgcn_readfirstlane(tid >> 6), lane = tid & 63, r = lane & 31, hf = lane >> 5;
  const int rp = (r & 0x13) | ((r & 4) << 1) | ((r & 8) >> 1);
  int h, Lk;
  long q0, kt0, vtb;
  if (idx < 1024) {
    const int q_ = idx >> 3;
    int b = q_ >> 4, qb = q_ & 15;
    h = idx & 7;
    q0 = T_P + (long)b * 4096 + qb * 256;
    kt0 = T_P + (long)b * 4608;
    Lk = 4608;
    vtb = (long)T_P * 512 + (long)b * 512 * 4608 + (long)h * 64 * 4608;
  } else {
    int j = idx - 1024;
    int b = j >> 3;
    h = j & 7;
    q0 = (long)b * 256;
    kt0 = (long)b * 256;
    Lk = 256;
    vtb = (long)b * 512 * 256 + (long)h * 64 * 256;
  }
  const u16* Q = (const u16*)lout(p) + Q_OFS;
  const u16* KNh = (const u16*)(lws(p) + WS_KNOPE) + h * 64;
  const u16* KR = (const u16*)(lws(p) + WS_KR);
  const u16* VT = (const u16*)(lws(p) + WS_VT) + vtb;
  const long qtok = q0 + wid * 64 + r;
  bf16x8 qf[2][6];
#pragma unroll
  for (int qi = 0; qi < 2; ++qi)
#pragma unroll
    for (int s = 0; s < 6; ++s) qf[qi][s] = *(const bf16x8*)(Q + (qtok + qi * 32) * 768 + h * 96 + 16 * s + 8 * hf);
  f32x16 o[2][2];
#pragma unroll
  for (int qi = 0; qi < 2; ++qi)
#pragma unroll
    for (int vt = 0; vt < 2; ++vt)
#pragma unroll
      for (int i = 0; i < 16; ++i) o[qi][vt][i] = 0.f;
  float mrun[2] = {0.f, 0.f}, lsum[2] = {0.f, 0.f};
  bool first = true, shifted = false;
  const int nst = Lk >> 6;
  attn_stage(KNh, KR, VT, kt0, 0, Lk, smem, tid);
  for (int t = 0; t < nst; ++t) {
    asm volatile("s_waitcnt vmcnt(0)" ::: "memory");
    __syncthreads();
    if (t + 1 < nst) attn_stage(KNh, KR, VT, kt0 + (t + 1) * 64, (t + 1) * 64, Lk, smem + ((t + 1) & 1) * ATT_STAGE, tid);
    const unsigned char* kb = smem + (t & 1) * ATT_STAGE;
    const unsigned char* vb = kb + ATT_KB;
#pragma unroll 1
    for (int u = 0; u < 2; ++u) {
      f32x16 st[2];
      if (!shifted) {
#pragma unroll
        for (int qi = 0; qi < 2; ++qi)
#pragma unroll
          for (int i = 0; i < 16; ++i) st[qi][i] = 0.f;
#pragma unroll
        for (int s = 0; s < 6; ++s) {
          bf16x8 kf = *(const bf16x8*)(kb + (u * 32 + rp) * 208 + (2 * s + hf) * 16);
          st[0] = __builtin_amdgcn_mfma_f32_32x32x16_bf16(kf, qf[0][s], st[0], 0, 0, 0);
          st[1] = __builtin_amdgcn_mfma_f32_32x32x16_bf16(kf, qf[1][s], st[1], 0, 0, 0);
        }
      } else {
#pragma unroll
        for (int qi = 0; qi < 2; ++qi)
#pragma unroll
          for (int i = 0; i < 16; ++i) st[qi][i] = -mrun[qi];
#pragma unroll
        for (int s = 0; s < 6; ++s) {
          bf16x8 kf = *(const bf16x8*)(kb + (u * 32 + rp) * 208 + (2 * s + hf) * 16);
          st[0] = __builtin_amdgcn_mfma_f32_32x32x16_bf16(kf, qf[0][s], st[0], 0, 0, 0);
          st[1] = __builtin_amdgcn_mfma_f32_32x32x16_bf16(kf, qf[1][s], st[1], 0, 0, 0);
        }
      }
      float mx[2];
#pragma unroll
      for (int qi = 0; qi < 2; ++qi) {
        float m = st[qi][0];
#pragma unroll
        for (int i = 1; i < 16; ++i) m = fmaxf(m, st[qi][i]);
        mx[qi] = xhalf_max(m);
      }
      if (__any((int)((mx[0] > 64.f) | (mx[1] > 64.f) | (first & ((mx[0] < -64.f) | (mx[1] < -64.f)))))) {
        shifted = true;
#pragma unroll
        for (int qi = 0; qi < 2; ++qi) {
          float mxc = first ? mx[qi] : fmaxf(mx[qi], 0.f);
          float alpha = __builtin_amdgcn_exp2f(-mxc);
          mrun[qi] += mxc;
          lsum[qi] *= alpha;
#pragma unroll
          for (int i = 0; i < 16; ++i) { st[qi][i] -= mxc; o[qi][0][i] *= alpha; o[qi][1][i] *= alpha; }
        }
      }
      first = false;
      bf16x8 pf[2][2];
#pragma unroll
      for (int qi = 0; qi < 2; ++qi) {
        float ps = 0.f;
#pragma unroll
        for (int i = 0; i < 16; ++i) { st[qi][i] = __builtin_amdgcn_exp2f(st[qi][i]); ps += st[qi][i]; }
        lsum[qi] += ps;
#pragma unroll
        for (int s = 0; s < 2; ++s) {
          u32x4 pw;
#pragma unroll
          for (int j2 = 0; j2 < 4; ++j2) pw[j2] = pk2(st[qi][8 * s + 2 * j2], st[qi][8 * s + 2 * j2 + 1]);
          pf[qi][s] = __builtin_bit_cast(bf16x8, pw);
        }
      }
#pragma unroll
      for (int s = 0; s < 2; ++s) {
        const int kofs = (u * 32 + 16 * s + 8 * hf) * 2;
#pragma unroll
        for (int vt = 0; vt < 2; ++vt) {
          bf16x8 vf = *(const bf16x8*)(vb + (32 * vt + r) * 144 + kofs);
          o[0][vt] = __builtin_amdgcn_mfma_f32_32x32x16_bf16(vf, pf[0][s], o[0][vt], 0, 0, 0);
          o[1][vt] = __builtin_amdgcn_mfma_f32_32x32x16_bf16(vf, pf[1][s], o[1][vt], 0, 0, 0);
        }
      }
    }
  }
  __syncthreads();
#pragma unroll
  for (int qi = 0; qi < 2; ++qi) {
    float ltot = lsum[qi] + __shfl_xor(lsum[qi], 32);
    float inv = 1.f / ltot;
    u16* AT = (u16*)(lws(p) + WS_ATT) + (qtok + qi * 32) * 512 + h * 64;
#pragma unroll
    for (int vt = 0; vt < 2; ++vt)
#pragma unroll
      for (int g = 0; g < 4; g += 2) {
        uint2 a = uint2{pk2(o[qi][vt][4 * g] * inv, o[qi][vt][4 * g + 1] * inv), pk2(o[qi][vt][4 * g + 2] * inv, o[qi][vt][4 * g + 3] * inv)};
        uint2 b = uint2{pk2(o[qi][vt][4 * g + 4] * inv, o[qi][vt][4 * g + 5] * inv), pk2(o[qi][vt][4 * g + 6] * inv, o[qi][vt][4 * g + 7] * inv)};
        auto rx = __builtin_amdgcn_permlane32_swap(a.x, b.x, false, false);
        auto ry = __builtin_amdgcn_permlane32_swap(a.y, b.y, false, false);
        *(u32x4*)(AT + 32 * vt + 8 * g + 8 * hf) = u32x4{rx[0], ry[0], rx[1], ry[1]};
      }
  }
}

__device__ __forceinline__ void merge_step(const Params& p, int layer, int t, int idx, const u16*& A, const u16*& W, int& K) {
  int pm, pn;
  tile_map_n8(t, pm, pn);
  const int br = idx >> 1;
  unsigned char* ws = lws(p);
  unsigned char* wt = lwt(p, layer);
  if ((idx & 1) == 0) { A = (const u16*)(ws + WS_H) + (long)pm * 128 * 1024; W = (const u16*)(wt + WT_GATE) + (long)(br * 1024 + pn * 128) * 1024; K = 1024; }
  else if (br == 0) { A = (const u16*)(ws + WS_F) + (long)pm * 128 * 512; W = (const u16*)(wt + WT_OF) + (long)pn * 128 * 512; K = 512; }
  else if (br == 1) { A = (const u16*)(ws + WS_ATT) + (long)pm * 128 * 512; W = (const u16*)(wt + WT_OMLA) + (long)pn * 128 * 512; K = 512; }
  else { A = (const u16*)(ws + WS_OG) + (long)pm * 128 * 256; W = (const u16*)(wt + WT_OGLA) + (long)pn * 128 * 256; K = 256; }
}

__device__ __forceinline__ void merge_tile(const Params& p, int layer, int t, int tn, bool pf, unsigned char* smem) {
  const int tid = ltid(), wid = __builtin_amdgcn_readfirstlane(tid >> 6), lane = tid & 63, wr = wid >> 1, wc = wid & 1, fr = lane & 15, fq = lane >> 4;
  int pm, pn;
  tile_map_n8(t, pm, pn);
  unsigned mg[4][4][2];
#pragma unroll
  for (int m = 0; m < 4; ++m)
#pragma unroll
    for (int n = 0; n < 4; ++n) { mg[m][n][0] = 0u; mg[m][n][1] = 0u; }
#pragma unroll 1
  for (int br = 0; br < 3; ++br) {
    unsigned gp[4][4][2];
    const u16 *A0, *W0, *A1, *W1, *A2, *W2;
    int K0, K1, K2;
    merge_step(p, layer, t, br * 2, A0, W0, K0);
    merge_step(p, layer, t, br * 2 + 1, A1, W1, K1);
    {
      f32x4 g[4][4];
      zero_acc(g);
      gemm_acc<2>(g, A0, K0, W0, K0, K0, smem, true, pf || br > 0, A1, K1, W1, K1);
#pragma unroll
      for (int m = 0; m < 4; ++m)
#pragma unroll
        for (int n = 0; n < 4; ++n) {
          gp[m][n][0] = pk2(sigmoidf_(g[m][n][0]), sigmoidf_(g[m][n][1]));
          gp[m][n][1] = pk2(sigmoidf_(g[m][n][2]), sigmoidf_(g[m][n][3]));
        }
    }
    f32x4 y[4][4];
    zero_acc(y);
    bool hasn = true;
    if (br < 2) merge_step(p, layer, t, br * 2 + 2, A2, W2, K2);
    else if (tn >= 0) merge_step(p, layer, tn, 0, A2, W2, K2);
    else { hasn = false; A2 = nullptr; W2 = nullptr; K2 = 0; }
    gemm_acc<2>(y, A1, K1, W1, K1, K1, smem, true, true, hasn ? A2 : nullptr, K2, W2, K2);
#pragma unroll
    for (int m = 0; m < 4; ++m)
#pragma unroll
      for (int n = 0; n < 4; ++n) {
        float r0 = bflo(mg[m][n][0]) + bflo(gp[m][n][0]) * y[m][n][0];
        float r1 = bfhi(mg[m][n][0]) + bfhi(gp[m][n][0]) * y[m][n][1];
        float r2 = bflo(mg[m][n][1]) + bflo(gp[m][n][1]) * y[m][n][2];
        float r3 = bfhi(mg[m][n][1]) + bfhi(gp[m][n][1]) * y[m][n][3];
        mg[m][n][0] = pk2(r0, r1);
        mg[m][n][1] = pk2(r2, r3);
      }
  }
  u16* MG = (u16*)(lws(p) + WS_MERGED);
#pragma unroll
  for (int m = 0; m < 4; ++m)
#pragma unroll
    for (int n = 0; n < 4; n += 2) {
      int tok = pm * 128 + wr * 64 + m * 16 + fr, col = pn * 128 + wc * 64 + n * 16;
      store_pair16(MG + (long)tok * 1024 + col, uint2{mg[m][n][0], mg[m][n][1]}, uint2{mg[m][n + 1][0], mg[m][n + 1][1]}, fq);
    }
}

__device__ __forceinline__ void resid_tile(const Params& p, int layer, int pm, int pn, const u16* A, int K, const u16* W, int gate_ofs, bool x_from_input, unsigned char* smem,
                                           int tn, bool pf, bool rev = false, bool to_h = false) {
  const int tid = ltid(), wid = __builtin_amdgcn_readfirstlane(tid >> 6), lane = tid & 63, wr = wid >> 1, wc = wid & 1, fr = lane & 15, fq = lane >> 4;
  f32x4 acc[4][4];
  zero_acc(acc);
  int pmn = 0, pnn = 0;
  if (tn >= 0) { tile_map_n8(tn, pmn, pnn); if (rev) pmn = 319 - pmn; }
  gemm_acc(acc, A + (long)pm * 128 * K, K, W + (long)pn * 128 * K, K, K, smem, true, pf,
           tn >= 0 ? A + (long)pmn * 128 * K : nullptr, K, W + (long)pnn * 128 * K, K);
  const float* mod = (const float*)(lws(p) + WS_MOD) + (layer * 9 + cond_index(pm * 128)) * 6144 + gate_ofs;
  float4 gv[4];
#pragma unroll
  for (int n = 0; n < 4; ++n) gv[n] = *(const float4*)(mod + pn * 128 + wc * 64 + n * 16 + fq * 4);
  const int lofs = ((fq & 1) << 4) + ((fq >> 1) << 3);
#pragma unroll
  for (int m = 0; m < 4; ++m) {
    int tok = pm * 128 + wr * 64 + m * 16 + fr;
    u16* xdst = (to_h ? (u16*)(lws(p) + WS_H) : (u16*)lout(p)) + (long)tok * 1024;
    uint2 o2[4];
    if (x_from_input) {
#pragma unroll
      for (int n = 0; n < 4; ++n) {
        int col = pn * 128 + wc * 64 + n * 16 + fq * 4;
        float4 xv = ((const float4*)x_in_row(p, 0, tok))[col >> 2];
        o2[n].x = pk2(xv.x + gv[n].x * acc[m][n][0], xv.y + gv[n].y * acc[m][n][1]);
        o2[n].y = pk2(xv.z + gv[n].z * acc[m][n][2], xv.w + gv[n].w * acc[m][n][3]);
      }
    } else {
      const u16* xsrc = (const u16*)lout(p) + (long)tok * 1024;
#pragma unroll
      for (int n = 0; n < 4; n += 2) {
        u32x4 w = *(const u32x4*)(xsrc + pn * 128 + wc * 64 + n * 16 + lofs);
        auto rx = __builtin_amdgcn_permlane16_swap(w[0], w[2], false, false);
        auto ry = __builtin_amdgcn_permlane16_swap(w[1], w[3], false, false);
        const unsigned ax = rx[0], bx = rx[1], ay = ry[0], by = ry[1];
        o2[n].x = pk2(bflo(ax) + gv[n].x * acc[m][n][0], bfhi(ax) + gv[n].y * acc[m][n][1]);
        o2[n].y = pk2(bflo(ay) + gv[n].z * acc[m][n][2], bfhi(ay) + gv[n].w * acc[m][n][3]);
        o2[n + 1].x = pk2(bflo(bx) + gv[n + 1].x * acc[m][n + 1][0], bfhi(bx) + gv[n + 1].y * acc[m][n + 1][1]);
        o2[n + 1].y = pk2(bflo(by) + gv[n + 1].z * acc[m][n + 1][2], bfhi(by) + gv[n + 1].w * acc[m][n + 1][3]);
      }
    }
#pragma unroll
    for (int n = 0; n < 4; n += 2) store_pair16(xdst + pn * 128 + wc * 64 + n * 16, o2[n], o2[n + 1], fq);
  }
}

__device__ __forceinline__ void ff1_tile(const Params& p, int layer, int t, int tn, bool pf, unsigned char* smem) {
  const int tid = ltid(), wid = __builtin_amdgcn_readfirstlane(tid >> 6), lane = tid & 63, wr = wid >> 1, wc = wid & 1, fr = lane & 15, fq = lane >> 4;
  int pm, pn, pmn = 0, pnn = 0;
  tile_map_n32(t, pm, pn);
  if (tn >= 0) tile_map_n32(tn, pmn, pnn);
  f32x4 acc[4][4];
  zero_acc(acc);
  const u16* Hb = (const u16*)(lws(p) + WS_H);
  const u16* Wb = (const u16*)(lwt(p, layer) + WT_FF1);
  gemm_acc(acc, Hb + (long)(pm * 128) * 1024, 1024, Wb + (long)pn * 128 * 1024, 1024, 1024, smem, true, pf,
           tn >= 0 ? Hb + (long)(pmn * 128) * 1024 : nullptr, 1024, Wb + (long)pnn * 128 * 1024, 1024);
  u16* U = (u16*)(lws(p) + WS_U);
#pragma unroll
  for (int m = 0; m < 4; ++m)
#pragma unroll
    for (int n = 0; n < 4; n += 2) {
      int row = pm * 128 + wr * 64 + m * 16 + fr, col = pn * 128 + wc * 64 + n * 16;
      uint2 ab[2];
#pragma unroll
      for (int h2 = 0; h2 < 2; ++h2) {
        float v[4];
#pragma unroll
        for (int j = 0; j < 4; ++j) { float a = fmaxf(acc[m][n + h2][j], 0.f); v[j] = a * a; }
        ab[h2] = uint2{pk2(v[0], v[1]), pk2(v[2], v[3])};
      }
      store_pair16_nt(U + (long)row * 4096 + col, ab[0], ab[1], fq);
    }
}

__device__ __forceinline__ void phase_final_norm(const Params& p) {
  const int lane = ltid() & 63;
  const int wg = lbid() * 4 + __builtin_amdgcn_readfirstlane(ltid() >> 6), nw = gridDim.x * 4;
  const float* g = pin(p, 27);
  constexpr int RB = 4;
  const int rpw = ((T_ALL + nw - 1) / nw + RB - 1) / RB * RB;
  float4 G[2][2];
#pragma unroll
  for (int i = 0; i < 2; ++i)
#pragma unroll
    for (int h2 = 0; h2 < 2; ++h2) G[i][h2] = ((const float4*)g)[(lane + 64 * i) * 2 + h2];
  for (int k = 0; k < rpw; k += RB) {
    const int t0 = wg * rpw + k;
    if (t0 >= T_ALL) break;
    float4 v[RB][2][2];
    float ss[RB];
#pragma unroll
    for (int q = 0; q < RB; ++q) {
      const u16* xs = (const u16*)(lws(p) + WS_H) + (long)(t0 + q) * 1024;
      float a = 0.f;
#pragma unroll
      for (int i = 0; i < 2; ++i) {
        u32x4 w = *(const u32x4*)(xs + (lane + 64 * i) * 8);
        v[q][i][0] = float4{bflo(w[0]), bfhi(w[0]), bflo(w[1]), bfhi(w[1])};
        v[q][i][1] = float4{bflo(w[2]), bfhi(w[2]), bflo(w[3]), bfhi(w[3])};
#pragma unroll
        for (int h2 = 0; h2 < 2; ++h2) a += v[q][i][h2].x * v[q][i][h2].x + v[q][i][h2].y * v[q][i][h2].y + v[q][i][h2].z * v[q][i][h2].z + v[q][i][h2].w * v[q][i][h2].w;
      }
      ss[q] = a;
    }
#pragma unroll
    for (int o = 32; o > 0; o >>= 1)
#pragma unroll
      for (int q = 0; q < RB; ++q) ss[q] += __shfl_xor(ss[q], o);
#pragma unroll
    for (int q = 0; q < RB; ++q) {
      const float r = rsqrtf(ss[q] * (1.f / 1024.f) + 1e-6f);
      float* x = lout(p) + (long)(t0 + q) * 1024;
#pragma unroll
      for (int i = 0; i < 2; ++i)
#pragma unroll
        for (int h2 = 0; h2 < 2; ++h2) {
          float4 x4 = v[q][i][h2], gg = G[i][h2];
          st_nt4(x + ((lane + 64 * i) * 2 + h2) * 4, float4{x4.x * r * gg.x, x4.y * r * gg.y, x4.z * r * gg.z, x4.w * r * gg.w});
        }
    }
  }
}

__device__ __forceinline__ void run_phase(const Params& p, int ph, unsigned char* smem) {
  if (ph == 2 * NPH_LAYER) { phase_final_norm(p); return; }
  const int layer = ph / NPH_LAYER, lp = ph % NPH_LAYER;
  const int lane = ltid() & 63;
  switch (lp) {
    case 0: phase_prep(p, layer, smem);
      break;
    case 1: phase_norm(p, layer, 0, layer == 0);
      break;
    case 2: phase_in_gemm(p, layer, smem); break;
    case 3: {
      const int n0 = 2560, n1 = 1024, n2 = T_ALL / 16, n3 = 4096 / 4;
      int it = lbid();
      for (; it < n0; it += gridDim.x) gla_local(p, layer, it, smem);
      for (; it < n0 + n1; it += gridDim.x) fourier_p1(p, it - n0, smem);
      for (; it < n0 + n1 + n2; it += gridDim.x) latent_prep_tokens<4>(p, layer, (it - n0 - n1) * 16 + __builtin_amdgcn_readfirstlane(ltid() >> 6) * 4, lane);
      for (; it < n0 + n1 + n2 + n3; it += gridDim.x) cache_convert_row(p, layer, (it - n0 - n1 - n2) * 4 + __builtin_amdgcn_readfirstlane(ltid() >> 6), lane);
    } break;
    case 4: {
      const int n0 = 2816, n1 = 1920, n2 = 1280, n3 = 2560;
      int it = lbid();
      for (; it < n0; it += gridDim.x) kvup_tile(p, layer, it, smem);
      for (; it < n0 + n1; it += gridDim.x) qup_tile(p, layer, it - n0, smem);
      for (; it < n0 + n1 + n2; it += gridDim.x) fourier_p2(p, it - n0 - n1, smem);
      for (; it < n0 + n1 + n2 + n3; it += gridDim.x) gla_scan_block(p, layer, it - n0 - n1 - n2);
    } break;
    case 5: {
      const int n0 = 1280, n1 = 2560;
      if (layer == 0 && ((lbid() >> 8) & 1) == 0) phase_prep(p, 1, smem);
      int it = lbid();
      for (; it < n0; it += gridDim.x) attn_item(p, it, smem);
      for (; it < n0 + n1; it += gridDim.x) gla_output(p, layer, it - n0, smem);
      if (layer == 0 && ((lbid() >> 8) & 1) == 1) phase_prep(p, 1, smem);
    } break;
    case 6: phase_norm(p, layer, 0, layer == 0); break;
    case 7:
      {
        bool pf = false;
        for (int t = lbid(); t < 320 * 8; t += gridDim.x) {
          int tn = t + gridDim.x;
          if (tn >= 320 * 8) tn = -1;
          merge_tile(p, layer, t, tn, pf, smem);
          pf = tn >= 0;
        }
      }
      break;
    case 8:
      {
        bool pf = false;
        for (int t = lbid(); t < 320 * 8; t += gridDim.x) {
          int tn = t + gridDim.x;
          if (tn >= 320 * 8) tn = -1;
          int pm, pn;
          tile_map_n8(t, pm, pn);
          resid_tile(p, layer, pm, pn, (const u16*)(lws(p) + WS_MERGED), 1024, (const u16*)(lwt(p, layer) + WT_OUT), 2048, layer == 0, smem, tn, pf);
          pf = tn >= 0;
        }
      }
      break;
    case 9: phase_norm(p, layer, 1, false); break;
    case 10:
      {
        bool pf = false;
        for (int t = lbid(); t < 320 * 32; t += gridDim.x) {
          int tn = t + gridDim.x;
          if (tn >= 320 * 32) tn = -1;
          ff1_tile(p, layer, t, tn, pf, smem);
          pf = tn >= 0;
        }
      }
      break;
    case 11:
      {
        bool pf = false;
        for (int t = lbid(); t < 320 * 8; t += gridDim.x) {
          int tn = t + gridDim.x;
          if (tn >= 320 * 8) tn = -1;
          int pm, pn;
          tile_map_n8(t, pm, pn);
          pm = 319 - pm;
          resid_tile(p, layer, pm, pn, (const u16*)(lws(p) + WS_U), 4096, (const u16*)(lwt(p, layer) + WT_FF2), 5120, false, smem, tn, pf, true, layer == 1);
          pf = tn >= 0;
        }
      }
      break;
  }
}

#if !MULTI_LAUNCH
__global__ void __launch_bounds__(256, 2) fwd_megakernel(Params p) {
  __shared__ __attribute__((aligned(16))) unsigned char smem[65536];
  cg::grid_group grid = cg::this_grid();
  if (p.ph_lo == 0x7fffffff) grid.sync();
  XcdBarrier xb = xcd_barrier_post((unsigned*)(p.ws + WS_BAR));
#if LAUNDER && !defined(UNROLL_PH)
#pragma unroll 1
  for (int ph = 0; ph < NPHASES; ++ph) {
    run_phase(p, ph, smem);
    if (ph + 1 < NPHASES) xcd_barrier(xb);
  }
#else
#define RP(ph) run_phase(p, ph, smem); xcd_barrier(xb);
  RP(0) RP(1) RP(2) RP(3) RP(4) RP(5) RP(7) RP(8) RP(9) RP(10) RP(11)
  RP(13) RP(14) RP(15) RP(16) RP(17) RP(19) RP(20) RP(21) RP(22) RP(23)
  run_phase(p, 24, smem);
#endif
}

#else
__global__ void __launch_bounds__(256, 2) fwd_phase_kernel(Params p) {
  __shared__ __attribute__((aligned(16))) unsigned char smem[65536];
  run_phase(p, p.ph_lo, smem);
}
#endif

extern "C" void kernel_launch(void* const* d_in, const int* in_sizes, int n_in, void* d_out, int out_size, void* d_ws, size_t ws_size, hipStream_t stream) {
  static int grid_blocks = 0;
  if (!grid_blocks) {
    if (n_in != 28 || ws_size < WS_END) { fprintf(stderr, "kernel_launch: bad n_in %d or ws %zu < %zu\n", n_in, ws_size, (size_t)WS_END); grid_blocks = -1; return; }
    int dev = 0, cus = 0, per_cu = 0;
    (void)hipGetDevice(&dev);
    (void)hipDeviceGetAttribute(&cus, hipDeviceAttributeMultiprocessorCount, dev);
#if MULTI_LAUNCH
    (void)hipOccupancyMaxActiveBlocksPerMultiprocessor(&per_cu, fwd_phase_kernel, 256, 0);
#else
    (void)hipOccupancyMaxActiveBlocksPerMultiprocessor(&per_cu, fwd_megakernel, 256, 0);
#endif
    if (per_cu > 2) per_cu = 2;
    if (per_cu < 1) per_cu = 1;
    grid_blocks = cus * per_cu;
  }
  if (grid_blocks < 0) return;
  Params p{};
  for (int i = 0; i < 28; ++i) p.in[i] = (const float*)d_in[i];
  p.out = (float*)d_out;
  p.ws = (unsigned char*)d_ws;
#if MULTI_LAUNCH
  for (int ph = 0; ph < NPHASES; ++ph) {
    p.ph_lo = ph; p.ph_hi = ph + 1;
    hipLaunchKernelGGL(fwd_phase_kernel, dim3(grid_blocks), dim3(256), 0, stream, p);
  }
#else
  p.ph_lo = 0; p.ph_hi = NPHASES;
  (void)hipMemsetAsync((unsigned char*)d_ws + WS_BAR, 0, 16384, stream);
  void* args[] = {&p};
  hipError_t e = hipLaunchCooperativeKernel((void*)fwd_megakernel, dim3(grid_blocks), dim3(256), args, 0, stream);
  if (e != hipSuccess) fprintf(stderr, "cooperative launch failed: %s (grid %d)\n", hipGetErrorString(e), grid_blocks);
#endif
}
```
